# Optimizing an MI355X kernel written in HIP

```python
import math
import jax
import jax.numpy as jnp
from jax import lax
import numpy as np

D_MODEL = 1024
BATCH = 4
SEQ = 4096
DEPTH = 2
DEC_BATCH = 8
DEC_SEQ = 2048
PAST_LEN = 128

GRID_W = 64
CHUNK = 128
A_WIDTH = D_MODEL // 2
A_GROUPS = 4
A_GROUP_DIM = A_WIDTH // A_GROUPS
NA_HEADS = 8
NA_HEAD_DIM = (D_MODEL - A_WIDTH) // NA_HEADS
NA_WIDTH = NA_HEADS * NA_HEAD_DIM
NA_KH_MAX = 8
NA_KW = 16
DIFF_HEADS = 8
DIFF_HEAD_DIM = D_MODEL // DIFF_HEADS // 2
DIFF_WIDTH = DIFF_HEADS * 2 * DIFF_HEAD_DIM
D_FF = 4 * D_MODEL
Q_BLOCK = 128
LN_EPS = 1e-5
DEEPNORM_ALPHA = (2 * DEPTH) ** 0.25
DEEPNORM_BETA = (8 * DEPTH) ** -0.25

kernel_name = "hybrid_gmlp_natten_diffattn_encoder"


def layer_norm(x, g, b):
    xf = x.astype(jnp.float32)
    mu = jnp.mean(xf, axis=-1, keepdims=True)
    var = jnp.mean(jnp.square(xf - mu), axis=-1, keepdims=True)
    return ((xf - mu) * lax.rsqrt(var + LN_EPS) * g + b).astype(x.dtype)


def rms_norm(x, g):
    xf = x.astype(jnp.float32)
    ms = jnp.mean(jnp.square(xf), axis=-1, keepdims=True)
    return (xf * lax.rsqrt(ms + LN_EPS) * g).astype(x.dtype)


def lambda_init(layer):
    return 0.8 - 0.6 * math.exp(-0.3 * layer)


def chunked_spatial_gating(z, ln_g, ln_b, w_s, b_s):
    B, T, _ = z.shape
    u, v = jnp.split(z, 2, axis=-1)
    v = layer_norm(v, ln_g, ln_b)
    nc = T // CHUNK
    v = v.reshape(B, nc, CHUNK, A_GROUPS, A_GROUP_DIM)
    mixed = jnp.einsum('gts,bnsgc->bntgc', w_s, v) + b_s.T[None, None, :, :, None]
    return u * mixed.reshape(B, T, A_WIDTH)


def neighbourhood_attention(q, k, v, rpb):
    B, T, H, dh = q.shape
    rows = T // GRID_W
    kh = min(NA_KH_MAX, rows)
    kw = NA_KW
    qg = q.reshape(B, rows, GRID_W, H, dh) * (dh ** -0.5)
    kg = k.reshape(B, rows, GRID_W, H, dh)
    vg = v.reshape(B, rows, GRID_W, H, dh)
    cols = jnp.arange(GRID_W)
    c_start = jnp.clip(cols - kw // 2, 0, GRID_W - kw)
    col_idx = c_start[:, None] + jnp.arange(kw)[None, :]
    col_off = col_idx - cols[:, None] + (NA_KW - 1)

    def one_row(r):
        r_start = jnp.clip(r - kh // 2, 0, rows - kh)
        k_rows = lax.dynamic_slice_in_dim(kg, r_start, kh, axis=1)
        v_rows = lax.dynamic_slice_in_dim(vg, r_start, kh, axis=1)
        k_win = k_rows[:, :, col_idx]
        v_win = v_rows[:, :, col_idx]
        q_row = lax.dynamic_index_in_dim(qg, r, axis=1, keepdims=False)
        s = jnp.einsum('bchd,bicjhd->bhcij', q_row, k_win).astype(jnp.float32)
        row_off = r_start + jnp.arange(kh) - r + (NA_KH_MAX - 1)
        bias = rpb[:, row_off][:, :, col_off]
        s = s + jnp.transpose(bias, (0, 2, 1, 3))[None]
        p = jax.nn.softmax(s.reshape(B, H, GRID_W, kh * kw), axis=-1)
        p = p.reshape(B, H, GRID_W, kh, kw).astype(v.dtype)
        return jnp.einsum('bhcij,bicjhd->bchd', p, v_win)

    out = lax.map(one_row, jnp.arange(rows))
    return jnp.transpose(out, (1, 0, 2, 3, 4)).reshape(B, T, H * dh)


def mixer_gmlp_natten(x, w_in, w_out, gate_ln_g, gate_ln_b, w_spatial, b_spatial, na_rpb):
    B, T, _ = x.shape
    h = x @ w_in
    z_a, q, k, v = jnp.split(h, [2 * A_WIDTH, 2 * A_WIDTH + NA_WIDTH, 2 * A_WIDTH + 2 * NA_WIDTH], axis=-1)
    out_a = chunked_spatial_gating(jax.nn.gelu(z_a), gate_ln_g, gate_ln_b, w_spatial, b_spatial)
    shp = (B, T, NA_HEADS, NA_HEAD_DIM)
    out_b = neighbourhood_attention(q.reshape(shp), k.reshape(shp), v.reshape(shp), na_rpb)
    return jnp.concatenate([out_a, out_b], axis=-1) @ w_out


def differential_attention(q, k, v, lam, lam_init):
    B, T, H, _, dh = q.shape
    nb = T // Q_BLOCK
    slopes = jnp.exp2(-8.0 * jnp.arange(1, H + 1, dtype=jnp.float32) / H)
    qb = jnp.transpose((q * (dh ** -0.5)).reshape(B, nb, Q_BLOCK, H, 2, dh), (1, 0, 2, 3, 4, 5))
    k_pos = jnp.arange(T)

    def one_block(args):
        q_blk, i = args
        q_pos = i * Q_BLOCK + jnp.arange(Q_BLOCK)
        dist = jnp.abs(q_pos[:, None] - k_pos[None, :]).astype(jnp.float32)
        bias = -slopes[:, None, None] * dist
        s = jnp.einsum('bqhnd,bkhnd->bhnqk', q_blk, k).astype(jnp.float32) + bias[None, :, None]
        p = jax.nn.softmax(s, axis=-1)
        p = (p[:, :, 0] - lam * p[:, :, 1]).astype(v.dtype)
        return jnp.einsum('bhqk,bkhe->bqhe', p, v)

    o = lax.map(one_block, (qb, jnp.arange(nb)))
    return jnp.transpose(o, (1, 0, 2, 3, 4)).reshape(B, T, H, 2 * dh)


def mixer_diff(x, w_in, w_out, lambda_q1, lambda_k1, lambda_q2, lambda_k2, subln_g, lam_init):
    B, T, _ = x.shape
    h = x @ w_in
    q, k, v = jnp.split(h, 3, axis=-1)
    q = q.reshape(B, T, DIFF_HEADS, 2, DIFF_HEAD_DIM)
    k = k.reshape(B, T, DIFF_HEADS, 2, DIFF_HEAD_DIM)
    v = v.reshape(B, T, DIFF_HEADS, 2 * DIFF_HEAD_DIM)
    lam1 = jnp.exp(jnp.sum((lambda_q1 * lambda_k1).astype(jnp.float32)))
    lam2 = jnp.exp(jnp.sum((lambda_q2 * lambda_k2).astype(jnp.float32)))
    lam = lam1 - lam2 + lam_init
    o = differential_attention(q, k, v, lam, lam_init)
    o = rms_norm(o, subln_g) * (1.0 - lam_init)
    return o.reshape(B, T, DIFF_WIDTH) @ w_out


def squared_relu_mlp(x, w1, w2):
    return jnp.square(jax.nn.relu(x @ w1)) @ w2


def setup_inputs(seed: int = 0) -> dict:
    key = jax.random.key(seed)
    ks = jax.random.split(key, 32)
    f32 = jnp.float32
    d = D_MODEL

    def nrm(k, shape, scale):
        return jax.random.normal(k, shape, f32) * scale

    def gain(k, n):
        return 1.0 + 0.02 * jax.random.normal(k, (n,), f32)

    w_in0 = nrm(ks[2], (d, 2 * A_WIDTH + 3 * NA_WIDTH), d ** -0.5)
    w_in0 = w_in0.at[:, 2 * A_WIDTH + 2 * NA_WIDTH:].multiply(DEEPNORM_BETA)
    w_in1 = nrm(ks[15], (d, 3 * DIFF_WIDTH), d ** -0.5)
    w_in1 = w_in1.at[:, 2 * DIFF_WIDTH:].multiply(DEEPNORM_BETA)
    return {
        "x_prompt": jax.random.normal(ks[0], (BATCH, SEQ, d), f32),
        "x_sample": jax.random.normal(ks[1], (DEC_BATCH, DEC_SEQ, d), f32),
        "l0_w_in": w_in0,
        "l0_w_out": nrm(ks[3], (A_WIDTH + NA_WIDTH, d), (A_WIDTH + NA_WIDTH) ** -0.5 * DEEPNORM_BETA),
        "l0_gate_ln_g": gain(ks[4], A_WIDTH),
        "l0_gate_ln_b": nrm(ks[5], (A_WIDTH,), 0.02),
        "l0_w_spatial": nrm(ks[6], (A_GROUPS, CHUNK, CHUNK), CHUNK ** -0.5),
        "l0_b_spatial": 1.0 + nrm(ks[7], (A_GROUPS, CHUNK), 0.02),
        "l0_na_rpb": nrm(ks[8], (NA_HEADS, 2 * NA_KH_MAX - 1, 2 * NA_KW - 1), 0.02),
        "l0_ln1_g": gain(ks[9], d),
        "l0_ln1_b": nrm(ks[10], (d,), 0.02),
        "l0_w_ff1": nrm(ks[11], (d, D_FF), d ** -0.5 * DEEPNORM_BETA),
        "l0_w_ff2": nrm(ks[12], (D_FF, d), D_FF ** -0.5 * DEEPNORM_BETA),
        "l0_ln2_g": gain(ks[13], d),
        "l0_ln2_b": nrm(ks[14], (d,), 0.02),
        "l1_w_in": w_in1,
        "l1_w_out": nrm(ks[16], (DIFF_WIDTH, d), DIFF_WIDTH ** -0.5 * DEEPNORM_BETA),
        "l1_lambda_q1": nrm(ks[17], (DIFF_HEAD_DIM,), 0.1),
        "l1_lambda_k1": nrm(ks[18], (DIFF_HEAD_DIM,), 0.1),
        "l1_lambda_q2": nrm(ks[19], (DIFF_HEAD_DIM,), 0.1),
        "l1_lambda_k2": nrm(ks[20], (DIFF_HEAD_DIM,), 0.1),
        "l1_subln_g": gain(ks[21], 2 * DIFF_HEAD_DIM),
        "l1_ln1_g": gain(ks[22], d),
        "l1_ln1_b": nrm(ks[23], (d,), 0.02),
        "l1_w_ff1": nrm(ks[24], (d, D_FF), d ** -0.5 * DEEPNORM_BETA),
        "l1_w_ff2": nrm(ks[25], (D_FF, d), D_FF ** -0.5 * DEEPNORM_BETA),
        "l1_ln2_g": gain(ks[26], d),
        "l1_ln2_b": nrm(ks[27], (d,), 0.02),
    }


def reference(x_prompt, x_sample, l0_w_in, l0_w_out, l0_gate_ln_g, l0_gate_ln_b, l0_w_spatial,
              l0_b_spatial, l0_na_rpb, l0_ln1_g, l0_ln1_b, l0_w_ff1, l0_w_ff2, l0_ln2_g, l0_ln2_b,
              l1_w_in, l1_w_out, l1_lambda_q1, l1_lambda_k1, l1_lambda_q2, l1_lambda_k2, l1_subln_g,
              l1_ln1_g, l1_ln1_b, l1_w_ff1, l1_w_ff2, l1_ln2_g, l1_ln2_b):
    ffn = [(l0_w_ff1, l0_w_ff2), (l1_w_ff1, l1_w_ff2)]
    ln1 = [(l0_ln1_g, l0_ln1_b), (l1_ln1_g, l1_ln1_b)]
    ln2 = [(l0_ln2_g, l0_ln2_b), (l1_ln2_g, l1_ln2_b)]

    def trunk(x):
        for layer in range(DEPTH):
            if layer % 2 == 0:
                mix = mixer_gmlp_natten(x, l0_w_in, l0_w_out, l0_gate_ln_g, l0_gate_ln_b,
                                        l0_w_spatial, l0_b_spatial, l0_na_rpb)
            else:
                mix = mixer_diff(x, l1_w_in, l1_w_out, l1_lambda_q1, l1_lambda_k1, l1_lambda_q2,
                                 l1_lambda_k2, l1_subln_g, lambda_init(layer))
            x = layer_norm(DEEPNORM_ALPHA * x + mix, *ln1[layer])
            x = layer_norm(DEEPNORM_ALPHA * x + squared_relu_mlp(x, *ffn[layer]), *ln2[layer])
        return x

    y_prompt = trunk(x_prompt)
    y_sample = trunk(x_sample)
    return (y_prompt, y_sample)
```

```cpp
#include <hip/hip_runtime.h>
#include <hip/hip_cooperative_groups.h>
#include <cstdio>
#include <cstdint>
namespace cg = cooperative_groups;
namespace pg8 {
#define PG8_LAS __attribute__((address_space(3)))
typedef unsigned short bf16_t;
typedef short bf16x8 __attribute__((ext_vector_type(8)));
typedef float f32x4 __attribute__((ext_vector_type(4)));
typedef unsigned u32x4 __attribute__((ext_vector_type(4)));
constexpr int BM = 256, BK = 64, HALF = 128, HTB = HALF * BK * 2  , STAGE_BYTES = 8 * HTB, NXCD = 8, WGM = 8;

__host__ __device__ __forceinline__ int lds_byte(int r, int c) { const int st = (r >> 4) * 2 + (c >> 5), rr = r & 15, cc = c & 31, ob = rr * 64 + cc * 2; return st * 1024 + (ob ^ (((ob >> 9) & 1) << 5)); }
__host__ __device__ __forceinline__ void stage_rc(int b, int& R, int& C) { const int st = b / 1024, sb = b % 1024, swz = sb ^ (((sb >> 9) & 1) << 5); R = (st >> 1) * 16 + swz / 64; C = (st & 1) * 32 + (swz % 64) / 2; }
__host__ __device__ __forceinline__ int perm32(int rho) { const int n = rho >> 4, i = rho & 15; return 8 * (i >> 2) + 4 * n + (i & 3); }

struct Unit { int pm, pn; };
struct Gemm { const bf16_t* A; const bf16_t* Bt; int M, N, K; };

struct StaticOrder {
    int nM, nN, nwg, G, c;
    __host__ __device__ void init(int M, int N, int G_, int c_) { nM = M / BM; nN = N / BM; nwg = nM * nN; G = G_; c = c_; }
    __host__ __device__ bool next(int i, Unit& u) const {
        const long L = (long)i * G + c; if (L >= nwg) return false;
        int wgid = (int)L; { const int q = nwg / NXCD, r = nwg % NXCD, xcd = wgid % NXCD, off = wgid / NXCD; wgid = (xcd < r ? xcd * (q + 1) : r * (q + 1) + (xcd - r) * q) + off; }
        const int nig = WGM * nN, gid = wgid / nig, fm = gid * WGM, gsz = (nM - fm) < WGM ? (nM - fm) : WGM;
        u.pm = fm + ((wgid % nig) % gsz); u.pn = (wgid % nig) / gsz; return true;
    }
    __device__ __forceinline__ void a_ready(const Unit&) const {}
    __device__ __forceinline__ void done(const Unit&) const {}
};

template <class Epi, class Sched, bool ALIGN_EPI = false, bool SP2 = false>
__device__ __forceinline__ void gemm_phase(PG8_LAS unsigned char* lds, const Gemm g, const Sched& S, const Epi& E) {
    int tid_o = threadIdx.x; asm volatile("" : "+v"(tid_o)); const int tid = tid_o, wid = __builtin_amdgcn_readfirstlane(tid >> 6), lane = tid & 63, wr = wid >> 2, wc = wid & 3, fr = lane & 15, fq = lane >> 4;
    const int K = g.K, nt = K / BK;
    unsigned voffA[2], voffB[2];
#pragma unroll
    for (int i = 0; i < 2; ++i) { int R, C; stage_rc(tid * 16 + i * 8192, R, C); const int Rb = Epi::PERM ? ((R & ~31) + perm32(R & 31)) : R;
        voffA[i] = (unsigned)(R * K + C) * 2u; voffB[i] = (unsigned)(Rb * K + C) * 2u; }
    const size_t kstep = (size_t)(BK * 2);
    const size_t hstep = (size_t)HALF * K * 2;
    const size_t tstep = 2 * hstep;
    const unsigned ldsw = (unsigned)wid * 1024u;
    const int aoff = lds_byte(wr * 64 + fr, fq * 8), boff = lds_byte(wc * 32 + fr, fq * 8);
#define PG8_SA(b, h) (((b) * 2 + (h)) * HTB)
#define PG8_SB(b, h) ((4 + (b) * 2 + (h)) * HTB)
#define PG8_STAGE(bufoff, gbase, voff) do { _Pragma("unroll") for (int _i = 0; _i < 2; ++_i) \
        __builtin_amdgcn_global_load_lds((const unsigned*)((const char*)(gbase) + (voff)[_i]), (PG8_LAS unsigned*)(lds + (bufoff) + ldsw + _i * 8192), 16, 0, 0); } while (0)
#define PG8_LDA(dst, b, h) do { _Pragma("unroll") for (int m = 0; m < 4; ++m) _Pragma("unroll") for (int k = 0; k < 2; ++k) dst[m][k] = *(const PG8_LAS bf16x8*)(lds + PG8_SA(b, h) + aoff + m * 2048 + k * 1024); } while (0)
#define PG8_LDB(dst, b, h) do { _Pragma("unroll") for (int n = 0; n < 2; ++n) _Pragma("unroll") for (int k = 0; k < 2; ++k) dst[n][k] = *(const PG8_LAS bf16x8*)(lds + PG8_SB(b, h) + boff + n * 2048 + k * 1024); } while (0)
#define PG8_MMA(ai, bj, At, Bt) do { __builtin_amdgcn_s_setprio(1); _Pragma("unroll") for (int m = 0; m < 4; ++m) _Pragma("unroll") for (int n = 0; n < 2; ++n) _Pragma("unroll") for (int k = 0; k < 2; ++k) \
        acc[ai][bj][m][n] = __builtin_amdgcn_mfma_f32_16x16x32_bf16(Bt[n][k], At[m][k], acc[ai][bj][m][n], 0, 0, 0); __builtin_amdgcn_s_setprio(0); } while (0)
#define PG8_WAIT_V(n) asm volatile("s_waitcnt vmcnt(" #n ")" ::: "memory")
#define PG8_WAIT_L(n) asm volatile("s_waitcnt lgkmcnt(" #n ")" ::: "memory")
#define PG8_BAR __builtin_amdgcn_s_barrier()
#define PG8_SCHED __builtin_amdgcn_sched_barrier(0)
    Unit cur, nxt; int ui = 0;
    if (!S.next(0, cur)) return;
    f32x4 acc[2][2][4][2];
#pragma unroll
    for (int a = 0; a < 2; ++a)
#pragma unroll
        for (int b = 0; b < 2; ++b)
#pragma unroll
            for (int m = 0; m < 4; ++m)
#pragma unroll
                for (int n = 0; n < 2; ++n) acc[a][b][m][n] = (f32x4){0.f, 0.f, 0.f, 0.f};
    bf16x8 At[4][2], B0[2][2], B1[2][2];
    const char* cA = (const char*)g.A + (size_t)cur.pm * tstep; const char* cB = (const char*)g.Bt + (size_t)cur.pn * tstep;
    S.a_ready(cur);
    if constexpr (SP2) {
        PG8_STAGE(PG8_SB(0, 0), cB, voffB); PG8_STAGE(PG8_SB(0, 1), cB + hstep, voffB); PG8_STAGE(PG8_SA(0, 0), cA, voffA); PG8_STAGE(PG8_SA(0, 1), cA + hstep, voffA);
        if (wr == 1) PG8_BAR;
        PG8_WAIT_V(2); PG8_BAR;
        PG8_STAGE(PG8_SB(1, 0), cB + kstep, voffB); PG8_STAGE(PG8_SA(1, 0), cA + kstep, voffA); PG8_STAGE(PG8_SB(1, 1), cB + hstep + kstep, voffB);
        PG8_WAIT_V(6); PG8_BAR;
    } else {
        PG8_STAGE(PG8_SB(0, 0), cB, voffB); PG8_STAGE(PG8_SA(0, 0), cA, voffA); PG8_STAGE(PG8_SB(0, 1), cB + hstep, voffB); PG8_STAGE(PG8_SA(0, 1), cA + hstep, voffA);
        if (wr == 1) PG8_BAR;
        PG8_WAIT_V(4); PG8_BAR;
        PG8_STAGE(PG8_SB(1, 0), cB + kstep, voffB); PG8_STAGE(PG8_SA(1, 0), cA + kstep, voffA); PG8_STAGE(PG8_SB(1, 1), cB + hstep + kstep, voffB);
        PG8_WAIT_V(6); PG8_BAR;
    }
    for (;;) {
        const bool has_next = S.next(ui + 1, nxt);
        const char* nA = has_next ? (const char*)g.A + (size_t)nxt.pm * tstep : cA; const char* nB = has_next ? (const char*)g.Bt + (size_t)nxt.pn * tstep : cB;
        for (int t = 0; t < nt; t += 2) {
            const bool last = (t == nt - 2);
            const char* a1 = cA + (size_t)(t + 1) * kstep;
            const char* a2 = last ? nA : cA + (size_t)(t + 2) * kstep; const char* b2 = last ? nB : cB + (size_t)(t + 2) * kstep;
            const char* a3 = a2 + kstep; const char* b3 = b2 + kstep;
            if (last && has_next) S.a_ready(nxt);
            if constexpr (SP2) {
            PG8_LDB(B0, 0, 0); PG8_LDB(B1, 0, 1); PG8_SCHED; PG8_LDA(At, 0, 0); PG8_STAGE(PG8_SA(1, 1), a1 + hstep, voffA);
            PG8_WAIT_V(8); PG8_WAIT_L(0); PG8_BAR; PG8_MMA(0, 0, At, B0); PG8_MMA(0, 1, At, B1); PG8_BAR; PG8_SCHED;
            PG8_LDA(At, 0, 1); PG8_STAGE(PG8_SB(0, 0), b2, voffB); PG8_STAGE(PG8_SB(0, 1), b2 + hstep, voffB); PG8_STAGE(PG8_SA(0, 0), a2, voffA);
            PG8_WAIT_V(8); PG8_WAIT_L(0); PG8_BAR; PG8_MMA(1, 0, At, B0); PG8_MMA(1, 1, At, B1); PG8_BAR; PG8_SCHED;
            PG8_LDB(B0, 1, 0); PG8_LDB(B1, 1, 1); PG8_SCHED; PG8_LDA(At, 1, 0); PG8_STAGE(PG8_SA(0, 1), a2 + hstep, voffA);
            PG8_WAIT_V(8); PG8_WAIT_L(0); PG8_BAR; PG8_MMA(0, 0, At, B0); PG8_MMA(0, 1, At, B1); PG8_BAR; PG8_SCHED;
            PG8_LDA(At, 1, 1); PG8_STAGE(PG8_SB(1, 0), b3, voffB); PG8_STAGE(PG8_SB(1, 1), b3 + hstep, voffB); PG8_STAGE(PG8_SA(1, 0), a3, voffA);
            PG8_WAIT_V(8); PG8_WAIT_L(0); PG8_BAR; PG8_MMA(1, 0, At, B0); PG8_MMA(1, 1, At, B1); PG8_BAR; PG8_SCHED;
            } else {
            PG8_LDB(B0, 0, 0); PG8_SCHED; PG8_LDA(At, 0, 0); PG8_STAGE(PG8_SA(1, 1), a1 + hstep, voffA);
            PG8_WAIT_L(8); PG8_BAR; PG8_WAIT_L(0); PG8_MMA(0, 0, At, B0); PG8_BAR; PG8_SCHED;
            PG8_LDB(B1, 0, 1); PG8_STAGE(PG8_SB(0, 0), b2, voffB);
            PG8_BAR; PG8_WAIT_L(0); PG8_MMA(0, 1, At, B1); PG8_BAR;
            PG8_LDA(At, 0, 1); PG8_STAGE(PG8_SA(0, 0), a2, voffA);
            PG8_BAR; PG8_WAIT_L(0); PG8_MMA(1, 0, At, B0); PG8_BAR; PG8_SCHED;
            PG8_STAGE(PG8_SB(0, 1), b2 + hstep, voffB);
            PG8_WAIT_V(6); PG8_BAR; PG8_MMA(1, 1, At, B1); PG8_BAR;
            PG8_LDB(B0, 1, 0); PG8_SCHED; PG8_LDA(At, 1, 0); PG8_STAGE(PG8_SA(0, 1), a2 + hstep, voffA);
            PG8_WAIT_L(8); PG8_BAR; PG8_WAIT_L(0); PG8_MMA(0, 0, At, B0); PG8_BAR; PG8_SCHED;
            PG8_LDB(B1, 1, 1); PG8_STAGE(PG8_SB(1, 0), b3, voffB);
            PG8_BAR; PG8_WAIT_L(0); PG8_MMA(0, 1, At, B1); PG8_BAR;
            PG8_LDA(At, 1, 1); PG8_STAGE(PG8_SA(1, 0), a3, voffA);
            PG8_BAR; PG8_WAIT_L(0); PG8_MMA(1, 0, At, B0); PG8_BAR; PG8_SCHED;
            PG8_STAGE(PG8_SB(1, 1), b3 + hstep, voffB);
            PG8_WAIT_V(6); PG8_BAR; PG8_MMA(1, 1, At, B1); PG8_BAR;
            }
        }
        if constexpr (ALIGN_EPI) { if (wr == 0) PG8_BAR; }
        if constexpr (!Epi::AFTER_DRAIN) { E(acc, cur, wr, wc, fr, fq); S.done(cur); }
        if (!has_next) break;
#pragma unroll
        for (int a = 0; a < 2; ++a)
#pragma unroll
            for (int b = 0; b < 2; ++b)
#pragma unroll
                for (int m = 0; m < 4; ++m)
#pragma unroll
                    for (int n = 0; n < 2; ++n) acc[a][b][m][n] = (f32x4){0.f, 0.f, 0.f, 0.f};
        cur = nxt; cA = nA; cB = nB; ++ui;
        if constexpr (ALIGN_EPI) { if (wr == 1) PG8_BAR; }
    }
    PG8_WAIT_V(0);
    if constexpr (!ALIGN_EPI) { if (wr == 0) PG8_BAR; }
    PG8_BAR;
    if constexpr (Epi::AFTER_DRAIN) { E.fused(acc, cur, wr, wc, fr, fq, lds, wid, lane); S.done(cur); }
#undef PG8_SA
#undef PG8_SB
#undef PG8_STAGE
#undef PG8_LDA
#undef PG8_LDB
#undef PG8_MMA
#undef PG8_WAIT_V
#undef PG8_WAIT_L
#undef PG8_BAR
#undef PG8_SCHED
}
}

#define LAS __attribute__((address_space(3)))
typedef unsigned short bf16_t;
typedef short bf16x8 __attribute__((ext_vector_type(8)));
typedef short s16x4 __attribute__((ext_vector_type(4)));
typedef float f32x4 __attribute__((ext_vector_type(4)));
typedef float f32x16 __attribute__((ext_vector_type(16)));
typedef unsigned u32x4 __attribute__((ext_vector_type(4)));
typedef unsigned u32x2 __attribute__((ext_vector_type(2)));
typedef float f32x2_t __attribute__((ext_vector_type(2)));
typedef __bf16 bf16x2_t __attribute__((ext_vector_type(2)));
#define DI __device__ __forceinline__
DI unsigned cvtpk(float lo, float hi) { f32x2_t v = {lo, hi}; bf16x2_t b = __builtin_convertvector(v, bf16x2_t); return __builtin_bit_cast(unsigned, b); }
DI float bf_lo(unsigned w) { return __uint_as_float(w << 16); }
DI float bf_hi(unsigned w) { return __uint_as_float(w & 0xffff0000u); }
DI float ex2(float x) { return __builtin_amdgcn_exp2f(x); }
DI f32x4 mfma16(bf16x8 a, bf16x8 b, f32x4 c) { return __builtin_amdgcn_mfma_f32_16x16x32_bf16(a, b, c, 0, 0, 0); }
DI f32x16 mfma32(bf16x8 a, bf16x8 b, f32x16 c) { return __builtin_amdgcn_mfma_f32_32x32x16_bf16(a, b, c, 0, 0, 0); }
DI s16x4 vtr(LAS const unsigned char* p) { typedef short v4i16_t __attribute__((ext_vector_type(4))); return __builtin_bit_cast(s16x4, __builtin_amdgcn_ds_read_tr16_b64_v4i16((LAS v4i16_t*)p)); }
DI float max3f(float a, float b, float c) { float r; asm("v_max3_f32 %0, %1, %2, %3" : "=v"(r) : "v"(a), "v"(b), "v"(c)); return r; }
DI bf16x8 cat8(s16x4 lo, s16x4 hi) { return (bf16x8){lo[0], lo[1], lo[2], lo[3], hi[0], hi[1], hi[2], hi[3]}; }

constexpr int M = 32768, MH = 16384, DM = 1024, FF = 4096;
constexpr float LN_EPS = 1e-5f, ALPHA = 1.4142135623730951f, LOG2E = 1.4426950408889634f;
constexpr float QS = 0.125f * LOG2E;
constexpr float LAM_INIT = 0.35550906759097f;
constexpr int NPHASE = 16;

constexpr size_t MiB = 1u << 20;
constexpr size_t WS_WIN0 = 0, WS_WOUT0 = 5 * MiB, WS_WFF1_0 = 7 * MiB, WS_WFF2_0 = 15 * MiB, WS_WIN1 = 23 * MiB, WS_WOUT1 = 29 * MiB, WS_WFF1_1 = 31 * MiB, WS_WFF2_1 = 39 * MiB;
constexpr size_t WS_WSP = 47 * MiB;
constexpr size_t WS_CP = 47 * MiB + 256 * 1024;
constexpr size_t WS_CF = 49 * MiB;
constexpr size_t WS_NRM = 49 * MiB + 128 * 1024;
constexpr size_t WS_CTL = 49 * MiB + 256 * 1024;
constexpr size_t WS_STA = 50 * MiB, WS_STB = 54 * MiB;
constexpr size_t WS_VST = 58 * MiB;
constexpr size_t WS_R1 = 60 * MiB;
constexpr size_t WS_R2 = 124 * MiB;
constexpr size_t WS_END = 252 * MiB;
constexpr size_t OUT_A = 0, OUT_B = 64 * MiB;
constexpr int CPS = 16 * 4096;
constexpr int LDS_BYTES = 147456;

struct Args { const float* in[28]; float* out; unsigned char* ws; int ph_lo, ph_hi; };

DI void row_stats16(const float* st, int row, int fq, float& mu, float& rstd) {
    const f32x4* p = (const f32x4*)(st + (size_t)row * 32 + fq * 8);
    const f32x4 a = p[0], b = p[1];
    float s = (a[0] + a[2]) + (b[0] + b[2]), ss = (a[1] + a[3]) + (b[1] + b[3]);
    s += __shfl_xor(s, 16); ss += __shfl_xor(ss, 16); s += __shfl_xor(s, 32); ss += __shfl_xor(ss, 32);
    mu = s * (1.f / 1024.f); const float var = fmaxf(ss * (1.f / 1024.f) - mu * mu, 0.f); rstd = rsqrtf(var + LN_EPS);
}
DI void put_stats(float* st, int row, int slot, int nslots, int fq, float s, float ss) {
    s += __shfl_xor(s, 16); ss += __shfl_xor(ss, 16); s += __shfl_xor(s, 32); ss += __shfl_xor(ss, 32);
    if (fq == 0) *(f32x2_t*)(st + ((size_t)row * nslots + slot) * 2) = (f32x2_t){s, ss};
}
DI float gelu_t(float x) {
    const float e = ex2(x * (-2.302208198f + (-0.10294324f) * x * x));
    return x * __builtin_amdgcn_rcpf(1.f + e);
}
DI u32x4 pack8(const f32x4 a, const f32x4 b) { u32x4 w; w[0] = cvtpk(a[0], a[1]); w[1] = cvtpk(a[2], a[3]); w[2] = cvtpk(b[0], b[1]); w[3] = cvtpk(b[2], b[3]); return w; }

struct EpiIn0 {
    static constexpr bool PERM = true, AFTER_DRAIN = false;
    bf16_t* UV; bf16_t* QKV; float* vst;
    DI void operator()(const f32x4 (&acc)[2][2][4][2], const pg8::Unit& u, int wr, int wc, int fr, int fq) const {
        const int colt = u.pn * 256;
        if (colt < 1024) {
            const bool isv = colt >= 512;
#pragma unroll
            for (int ai = 0; ai < 2; ++ai)
#pragma unroll
                for (int m = 0; m < 4; ++m) {
                    const int row = u.pm * 256 + ai * 128 + wr * 64 + m * 16 + fr;
                    float s = 0.f, ss = 0.f;
#pragma unroll
                    for (int bj = 0; bj < 2; ++bj) {
                        const int col = colt + bj * 128 + wc * 32 + 8 * fq;
                        f32x4 v0, v1;
#pragma unroll
                        for (int e = 0; e < 4; ++e) { v0[e] = gelu_t(acc[ai][bj][m][0][e]); v1[e] = gelu_t(acc[ai][bj][m][1][e]); }
#pragma unroll
                        for (int e = 0; e < 4; ++e) { s += v0[e] + v1[e]; ss += v0[e] * v0[e] + v1[e] * v1[e]; }
                        *(u32x4*)(UV + (size_t)row * 1024 + col) = pack8(v0, v1);
                    }
                    if (isv) put_stats(vst, row, (u.pn - 2) * 4 + wc, 8, fq, s, ss);
                }
        } else {
            const float sc = (colt < 1536) ? QS : 1.f;
#pragma unroll
            for (int ai = 0; ai < 2; ++ai)
#pragma unroll
                for (int m = 0; m < 4; ++m) {
                    const int row = u.pm * 256 + ai * 128 + wr * 64 + m * 16 + fr;
#pragma unroll
                    for (int bj = 0; bj < 2; ++bj) {
                        const int col = colt - 1024 + bj * 128 + wc * 32 + 8 * fq;
                        *(u32x4*)(QKV + (size_t)row * 1536 + col) = pack8(acc[ai][bj][m][0] * sc, acc[ai][bj][m][1] * sc);
                    }
                }
        }
    }
};

template <int SRC, bool OUTF32> struct EpiRes {
    static constexpr bool PERM = true, AFTER_DRAIN = false;
    const float* xa; const float* xb; const bf16_t* Yin; const float* stin; const float* g; const float* b;
    bf16_t* Yout; float* stout; float* Fout; int row_off;
    DI void operator()(const f32x4 (&acc)[2][2][4][2], const pg8::Unit& u, int wr, int wc, int fr, int fq) const {
        f32x4 gv[2][2], bv[2][2];
        if (SRC == 1) {
#pragma unroll
            for (int bj = 0; bj < 2; ++bj)
#pragma unroll
                for (int n = 0; n < 2; ++n) { const int col = u.pn * 256 + bj * 128 + wc * 32 + 8 * fq + 4 * n; gv[bj][n] = *(const f32x4*)(g + col) * ALPHA; bv[bj][n] = *(const f32x4*)(b + col) * ALPHA; }
        }
#pragma unroll
        for (int ai = 0; ai < 2; ++ai)
#pragma unroll
            for (int m = 0; m < 4; ++m) {
                const int row = row_off + u.pm * 256 + ai * 128 + wr * 64 + m * 16 + fr;
                float mu = 0.f, rstd = 0.f;
                if (SRC == 1) row_stats16(stin, row, fq, mu, rstd);
                float s = 0.f, ss = 0.f;
#pragma unroll
                for (int bj = 0; bj < 2; ++bj) {
                    const int col = u.pn * 256 + bj * 128 + wc * 32 + 8 * fq;
                    f32x4 r0, r1;
                    if (SRC == 0) {
                        const float* xp = (row < MH) ? xa + (size_t)row * 1024 : xb + (size_t)(row - MH) * 1024;
                        r0 = *(const f32x4*)(xp + col) * ALPHA; r1 = *(const f32x4*)(xp + col + 4) * ALPHA;
                    } else {
                        const u32x4 yw = *(const u32x4*)(Yin + (size_t)row * 1024 + col);
                        const f32x4 y0 = {bf_lo(yw[0]), bf_hi(yw[0]), bf_lo(yw[1]), bf_hi(yw[1])}, y1 = {bf_lo(yw[2]), bf_hi(yw[2]), bf_lo(yw[3]), bf_hi(yw[3])};
                        r0 = (y0 - mu) * rstd * gv[bj][0] + bv[bj][0]; r1 = (y1 - mu) * rstd * gv[bj][1] + bv[bj][1];
                    }
                    const f32x4 o0 = r0 + acc[ai][bj][m][0], o1 = r1 + acc[ai][bj][m][1];
                    if (OUTF32) { float* op = Fout + (size_t)row * 1024 + col; *(f32x4*)op = o0; *(f32x4*)(op + 4) = o1; }
                    else {
#pragma unroll
                        for (int e = 0; e < 4; ++e) { s += o0[e] + o1[e]; ss += o0[e] * o0[e] + o1[e] * o1[e]; }
                        *(u32x4*)(Yout + (size_t)row * 1024 + col) = pack8(o0, o1);
                    }
                }
                if (!OUTF32) put_stats(stout, row, u.pn * 4 + wc, 16, fq, s, ss);
            }
    }
};

template <int ACT> struct EpiFold {
    static constexpr bool PERM = true, AFTER_DRAIN = false;
    const float* stin; const float* c1; const float* c2; bf16_t* O; int ldo; int row_off; unsigned* nrm;
    DI void operator()(const f32x4 (&acc)[2][2][4][2], const pg8::Unit& u, int wr, int wc, int fr, int fq) const {
        const int colt = u.pn * 256;
        float nm[2] = {0.f, 0.f};
        f32x4 c1v[2][2], c2v[2][2];
#pragma unroll
        for (int bj = 0; bj < 2; ++bj)
#pragma unroll
            for (int n = 0; n < 2; ++n) { const int col = colt + bj * 128 + wc * 32 + 8 * fq + 4 * n; c1v[bj][n] = *(const f32x4*)(c1 + col); c2v[bj][n] = *(const f32x4*)(c2 + col); }
        const float sc = (ACT == 1 && colt < 1024) ? QS : 1.f;
#pragma unroll
        for (int ai = 0; ai < 2; ++ai)
#pragma unroll
            for (int m = 0; m < 4; ++m) {
                const int lrow = u.pm * 256 + ai * 128 + wr * 64 + m * 16 + fr;
                float mu, rstd; row_stats16(stin, row_off + lrow, fq, mu, rstd);
#pragma unroll
                for (int bj = 0; bj < 2; ++bj) {
                    const int col = colt + bj * 128 + wc * 32 + 8 * fq;
                    f32x4 t0 = (acc[ai][bj][m][0] - mu * c1v[bj][0]) * rstd + c2v[bj][0], t1 = (acc[ai][bj][m][1] - mu * c1v[bj][1]) * rstd + c2v[bj][1];
                    if (ACT == 0) {
#pragma unroll
                        for (int e = 0; e < 4; ++e) { const float a0 = fmaxf(t0[e], 0.f), a1 = fmaxf(t1[e], 0.f); t0[e] = a0 * a0; t1[e] = a1 * a1; }
                    } else {
                        t0 = t0 * sc; t1 = t1 * sc;
                        float q = ((t0[0] * t0[0] + t0[1] * t0[1]) + (t0[2] * t0[2] + t0[3] * t0[3])) + ((t1[0] * t1[0] + t1[1] * t1[1]) + (t1[2] * t1[2] + t1[3] * t1[3]));
                        q += __shfl_xor(q, 16); q += __shfl_xor(q, 32); nm[bj] = fmaxf(nm[bj], q);
                    }
                    *(u32x4*)(O + (size_t)lrow * ldo + col) = pack8(t0, t1);
                }
            }
        if (ACT == 1 && colt < 2048) {
            const int row0 = u.pm * 256, seq = (row0 < MH) ? (row0 >> 12) : 4 + ((row0 - MH) >> 11);
#pragma unroll
            for (int bj = 0; bj < 2; ++bj) {
                float v = nm[bj];
                v = fmaxf(v, __shfl_xor(v, 1)); v = fmaxf(v, __shfl_xor(v, 2)); v = fmaxf(v, __shfl_xor(v, 4)); v = fmaxf(v, __shfl_xor(v, 8));
                if (fr == 0 && fq == 0) atomicMax(nrm + seq * 64 + ((colt + bj * 128 + wc * 32) >> 5), __float_as_uint(v));
            }
        }
    }
};

DI void p0_item(const float* W, int K, int N, bf16_t* WT, LAS float* scr, int item, int lane, const float* g, const float* b, float* c1p, float* c2p) {
    const int nblk = N / 32, kb = item / nblk, nb = item % nblk, k0 = 64 * kb, n0 = 32 * nb;
    float a1 = 0.f, a2 = 0.f;
    float wv[32];
#pragma unroll
    for (int i = 0; i < 32; ++i) wv[i] = W[(size_t)(k0 + 2 * i + (lane >> 5)) * N + n0 + (lane & 31)];
#pragma unroll
    for (int i = 0; i < 32; ++i) {
        const int kk = 2 * i + (lane >> 5);
        float w = wv[i];
        if (g) { const float gw = w * g[k0 + kk]; a1 += bf_lo(cvtpk(gw, 0.f)); a2 += b[k0 + kk] * w; w = gw; }
        scr[kk * 33 + (lane & 31)] = w;
    }
    if (g) {
        a1 += __shfl_xor(a1, 32); a2 += __shfl_xor(a2, 32);
        if (lane < 32) { c1p[kb * 4096 + n0 + lane] = a1; c2p[kb * 4096 + n0 + lane] = a2; }
    }
    asm volatile("s_waitcnt lgkmcnt(0)" ::: "memory");
    const int c = lane & 7;
#pragma unroll
    for (int j = 0; j < 4; ++j) {
        const int n = (lane >> 3) + 8 * j; const LAS float* s = scr + (8 * c) * 33 + n;
        u32x4 o; o[0] = cvtpk(s[0 * 33], s[1 * 33]); o[1] = cvtpk(s[2 * 33], s[3 * 33]); o[2] = cvtpk(s[4 * 33], s[5 * 33]); o[3] = cvtpk(s[6 * 33], s[7 * 33]);
        *(u32x4*)(WT + (size_t)(n0 + n) * K + k0 + 8 * c) = o;
    }
    asm volatile("s_waitcnt lgkmcnt(0)" ::: "memory");
}

DI void phase_prologue(const Args& a, LAS unsigned char* lds, int bx, int G) {
    const int tid = threadIdx.x, lane = tid & 63, wave = tid >> 6;
    LAS float* scr = (LAS float*)(lds + wave * 16384);
    const int gw = bx * 8 + wave, NGW = G * 8;
    unsigned char* ws = a.ws;
    constexpr int I_IN0 = 16 * 80, I_OUT = 16 * 32, I_FF1 = 16 * 128, I_FF2 = 64 * 32, I_IN1 = 16 * 96;
    constexpr int NIT = I_IN0 + I_OUT + I_FF1 + I_FF2 + I_IN1 + I_OUT + I_FF1 + I_FF2;
    float* cp = (float*)(ws + WS_CP);
    for (int it = gw; it < NIT; it += NGW) {
        int r = it;
        if (r < I_IN0) { p0_item(a.in[2], 1024, 2560, (bf16_t*)(ws + WS_WIN0), scr, r, lane, nullptr, nullptr, nullptr, nullptr); continue; } r -= I_IN0;
        if (r < I_OUT) { p0_item(a.in[3], 1024, 1024, (bf16_t*)(ws + WS_WOUT0), scr, r, lane, nullptr, nullptr, nullptr, nullptr); continue; } r -= I_OUT;
        if (r < I_FF1) { p0_item(a.in[11], 1024, 4096, (bf16_t*)(ws + WS_WFF1_0), scr, r, lane, a.in[9], a.in[10], cp + 0 * CPS, cp + 1 * CPS); continue; } r -= I_FF1;
        if (r < I_FF2) { p0_item(a.in[12], 4096, 1024, (bf16_t*)(ws + WS_WFF2_0), scr, r, lane, nullptr, nullptr, nullptr, nullptr); continue; } r -= I_FF2;
        if (r < I_IN1) { p0_item(a.in[15], 1024, 3072, (bf16_t*)(ws + WS_WIN1), scr, r, lane, a.in[13], a.in[14], cp + 2 * CPS, cp + 3 * CPS); continue; } r -= I_IN1;
        if (r < I_OUT) { p0_item(a.in[16], 1024, 1024, (bf16_t*)(ws + WS_WOUT1), scr, r, lane, nullptr, nullptr, nullptr, nullptr); continue; } r -= I_OUT;
        if (r < I_FF1) { p0_item(a.in[24], 1024, 4096, (bf16_t*)(ws + WS_WFF1_1), scr, r, lane, a.in[22], a.in[23], cp + 4 * CPS, cp + 5 * CPS); continue; } r -= I_FF1;
        p0_item(a.in[25], 4096, 1024, (bf16_t*)(ws + WS_WFF2_1), scr, r, lane, nullptr, nullptr, nullptr, nullptr);
    }
    bf16_t* XB = (bf16_t*)((unsigned char*)a.out + OUT_A);
    for (int m0 = gw * 4; m0 < M; m0 += NGW * 4) {
        f32x4 v[4][4];
#pragma unroll
        for (int rr = 0; rr < 4; ++rr) { const int m = m0 + rr; const float* xr = (m < MH) ? a.in[0] + (size_t)m * 1024 : a.in[1] + (size_t)(m - MH) * 1024;
#pragma unroll
            for (int j = 0; j < 4; ++j) v[rr][j] = ((const f32x4*)xr)[lane + 64 * j]; }
#pragma unroll
        for (int rr = 0; rr < 4; ++rr)
#pragma unroll
            for (int j = 0; j < 4; ++j) { u32x2 o; o[0] = cvtpk(v[rr][j][0], v[rr][j][1]); o[1] = cvtpk(v[rr][j][2], v[rr][j][3]); ((u32x2*)(XB + (size_t)(m0 + rr) * 1024))[lane + 64 * j] = o; }
    }
    if (bx == 0) { for (int i = tid; i < 768; i += 512) ((unsigned*)(ws + WS_NRM))[i] = 0u; }
    for (int i = bx * 512 + tid; i < 32768; i += G * 512) { const f32x2_t w = ((const f32x2_t*)a.in[6])[i]; ((unsigned*)(ws + WS_WSP))[i] = cvtpk(w[0], w[1]); }
}

DI void fold_finalize(const Args& a, int bx, int G) {
    const float* cp = (const float*)(a.ws + WS_CP); float* cf = (float*)(a.ws + WS_CF);
    for (int idx = bx * 512 + (int)threadIdx.x; idx < 6 * 4096; idx += G * 512) {
        const int slot = idx >> 12, n = idx & 4095; const float* p = cp + (size_t)slot * CPS + n; float s = 0.f;
#pragma unroll
        for (int kb = 0; kb < 16; ++kb) s += p[kb * 4096];
        cf[idx] = s;
    }
}

DI void gate_unit(const Args& a, LAS unsigned char* lds, int u) {
    const int tid = threadIdx.x, lane = tid & 63, w = tid >> 6, fr = lane & 15, fq = lane >> 4;
    const int n = u >> 2, g = u & 3, t0 = n * 128;
    const bf16_t* UV = (const bf16_t*)(a.ws + WS_R1);
    const float* vst = (const float*)(a.ws + WS_VST);
    const float* lng = a.in[4]; const float* lnb = a.in[5];
#pragma unroll
    for (int k = 0; k < 4; ++k) {
        const int idx = tid + 512 * k, s = idx >> 4, ch = idx & 15, tok = t0 + s;
        const u32x4 vw = *(const u32x4*)(UV + (size_t)tok * 1024 + 512 + g * 128 + ch * 8);
        const f32x4* sp = (const f32x4*)(vst + (size_t)tok * 16);
        const f32x4 p0 = sp[0], p1 = sp[1], p2 = sp[2], p3 = sp[3];
        const float sm = ((p0[0] + p0[2]) + (p1[0] + p1[2])) + ((p2[0] + p2[2]) + (p3[0] + p3[2]));
        const float sq = ((p0[1] + p0[3]) + (p1[1] + p1[3])) + ((p2[1] + p2[3]) + (p3[1] + p3[3]));
        const float mu = sm * (1.f / 512.f), rstd = rsqrtf(fmaxf(sq * (1.f / 512.f) - mu * mu, 0.f) + LN_EPS);
        const f32x4 g0 = *(const f32x4*)(lng + g * 128 + ch * 8), g1 = *(const f32x4*)(lng + g * 128 + ch * 8 + 4);
        const f32x4 b0 = *(const f32x4*)(lnb + g * 128 + ch * 8), b1 = *(const f32x4*)(lnb + g * 128 + ch * 8 + 4);
        const f32x4 v0 = {bf_lo(vw[0]), bf_hi(vw[0]), bf_lo(vw[1]), bf_hi(vw[1])}, v1 = {bf_lo(vw[2]), bf_hi(vw[2]), bf_lo(vw[3]), bf_hi(vw[3])};
        *(LAS u32x4*)(lds + s * 288 + ch * 16) = pack8((v0 - mu) * rstd * g0 + b0, (v1 - mu) * rstd * g1 + b1);
    }
    __syncthreads();
    const bf16_t* Wsb = (const bf16_t*)(a.ws + WS_WSP) + (size_t)g * 16384 + (size_t)(16 * w + fr) * 128;
    bf16x8 bw[4];
#pragma unroll
    for (int ks = 0; ks < 4; ++ks) { const u32x2 lo = *(const u32x2*)(Wsb + 32 * ks + 4 * fq), hi = *(const u32x2*)(Wsb + 32 * ks + 16 + 4 * fq); u32x4 t; t[0] = lo[0]; t[1] = lo[1]; t[2] = hi[0]; t[3] = hi[1]; bw[ks] = __builtin_bit_cast(bf16x8, t); }
    const float bsv = a.in[7][g * 128 + 16 * w + fr];
    const int i16 = lane & 15, qq = i16 >> 2, p = i16 & 3;
    LAS const unsigned char* tb = lds + (4 * fq + qq) * 288 + p * 8;
    const size_t orow = (size_t)(t0 + 16 * w + fr) * 1024 + g * 128;
    bf16_t* CAT = (bf16_t*)((unsigned char*)a.out + OUT_B);
#pragma unroll
    for (int ct = 0; ct < 8; ++ct) {
        f32x4 acc = {0.f, 0.f, 0.f, 0.f};
#pragma unroll
        for (int ks = 0; ks < 4; ++ks) { const s16x4 lo = vtr(tb + (32 * ks) * 288 + ct * 32), hi = vtr(tb + (32 * ks + 16) * 288 + ct * 32); acc = mfma16(cat8(lo, hi), bw[ks], acc); }
        const int c = 16 * ct + 4 * fq;
        const u32x2 uw = *(const u32x2*)(UV + orow + c);
        u32x2 o; o[0] = cvtpk(bf_lo(uw[0]) * (acc[0] + bsv), bf_hi(uw[0]) * (acc[1] + bsv)); o[1] = cvtpk(bf_lo(uw[1]) * (acc[2] + bsv), bf_hi(uw[1]) * (acc[3] + bsv));
        *(u32x2*)(CAT + orow + c) = o;
    }
    __syncthreads();
}

DI void na_unit(const Args& a, LAS unsigned char* lds, int u) {
    const int tid = threadIdx.x, lane = tid & 63, w = tid >> 6, fr = lane & 15, fq = lane >> 4;
    int h, rp, rows, tok0;
    if (u < 1024) { h = u & 7; rp = (u >> 3) & 31; rows = 64; tok0 = (u >> 8) * 4096; }
    else { const int v = u - 1024; h = v & 7; rp = (v >> 3) & 15; rows = 32; tok0 = MH + (v >> 7) * 2048; }
    const int r0 = 2 * rp;
    const int s0 = min(max(r0 - 4, 0), rows - 8), s1 = min(max(r0 - 3, 0), rows - 8);
    const int nrl = s1 + 8 - s0;
    const bf16_t* QKV = (const bf16_t*)(a.ws + WS_R2);
    LAS float* rpl = (LAS float*)(lds + 9 * 64 * 160);
    for (int idx = tid; idx < nrl * 512; idx += 512) {
        const int key = idx >> 3, ch = idx & 7;
        const u32x4 v = *(const u32x4*)(QKV + (size_t)(tok0 + s0 * 64 + key) * 1536 + 1024 + h * 64 + ch * 8);
        *(LAS u32x4*)(lds + key * 160 + ch * 16) = v;
    }
    for (int i = tid; i < 465; i += 512) rpl[i] = a.in[8][h * 465 + i] * LOG2E;
    __syncthreads();
    const int qr = w >> 2, j = w & 3, r = r0 + qr, s = qr ? s1 : s0, rowoff = s - s0;
    const int wc0 = (j == 0) ? 0 : (j == 1) ? 8 : (j == 2) ? 24 : 32;
    const size_t qtok = (size_t)(tok0 + r * 64 + 16 * j + fr);
    bf16x8 qf[2];
#pragma unroll
    for (int ks = 0; ks < 2; ++ks) qf[ks] = *(const bf16x8*)(QKV + qtok * 1536 + h * 64 + 32 * ks + 8 * fq);
    f32x4 S[16];
#pragma unroll
    for (int st = 0; st < 16; ++st) {
        const int i = st >> 1, ch = st & 1;
        const bf16_t* kp = QKV + (size_t)(tok0 + (s + i) * 64 + wc0 + 16 * ch + fr) * 1536 + 512 + h * 64 + 8 * fq;
        const bf16x8 k0 = *(const bf16x8*)kp, k1 = *(const bf16x8*)(kp + 32);
        f32x4 z = {0.f, 0.f, 0.f, 0.f}; z = mfma16(k0, qf[0], z); S[st] = mfma16(k1, qf[1], z);
    }
    const int c = 16 * j + fr, cs = min(max(c - 8, 0), 48);
    float mx = -1e30f;
#pragma unroll
    for (int st = 0; st < 16; ++st) {
        const int i = st >> 1, ch = st & 1;
#pragma unroll
        for (int rr = 0; rr < 4; ++rr) {
            const int kc = wc0 + 16 * ch + 4 * fq + rr;
            const bool valid = (kc >= cs) && (kc < cs + 16);
            const int ci = min(max(kc - c + 15, 0), 30);
            const float bias = rpl[(s + i - r + 7) * 31 + ci];
            const float v = valid ? S[st][rr] + bias : -1e30f;
            S[st][rr] = v; mx = fmaxf(mx, v);
        }
    }
    mx = fmaxf(mx, __shfl_xor(mx, 16)); mx = fmaxf(mx, __shfl_xor(mx, 32));
    float l = 0.f;
#pragma unroll
    for (int st = 0; st < 16; ++st)
#pragma unroll
        for (int rr = 0; rr < 4; ++rr) { const float pe = ex2(S[st][rr] - mx); S[st][rr] = pe; l += pe; }
    l += __shfl_xor(l, 16); l += __shfl_xor(l, 32);
    const float inv = 1.f / l;
    bf16x8 pf[8];
#pragma unroll
    for (int i = 0; i < 8; ++i) { u32x4 t; t[0] = cvtpk(S[2 * i][0], S[2 * i][1]); t[1] = cvtpk(S[2 * i][2], S[2 * i][3]); t[2] = cvtpk(S[2 * i + 1][0], S[2 * i + 1][1]); t[3] = cvtpk(S[2 * i + 1][2], S[2 * i + 1][3]); pf[i] = __builtin_bit_cast(bf16x8, t); }
    const int i16 = lane & 15, qq = i16 >> 2, p = i16 & 3;
    LAS const unsigned char* vb = lds + (rowoff * 64 + wc0 + 4 * fq + qq) * 160 + p * 8;
    bf16_t* CAT = (bf16_t*)((unsigned char*)a.out + OUT_B) + qtok * 1024 + 512 + h * 64;
#pragma unroll
    for (int dt = 0; dt < 4; ++dt) {
        f32x4 o = {0.f, 0.f, 0.f, 0.f};
#pragma unroll
        for (int i = 0; i < 8; ++i) { const s16x4 lo = vtr(vb + (i * 64) * 160 + dt * 32), hi = vtr(vb + (i * 64 + 16) * 160 + dt * 32); o = mfma16(cat8(lo, hi), pf[i], o); }
        u32x2 ov; ov[0] = cvtpk(o[0] * inv, o[1] * inv); ov[1] = cvtpk(o[2] * inv, o[3] * inv);
        *(u32x2*)(CAT + 16 * dt + 4 * fq) = ov;
    }
    __syncthreads();
}

constexpr int AT_KB = 64 * 272, AT_VB = 64 * 320, AT_BUF = AT_KB + AT_VB;
DI void attn_unit(const Args& a, LAS unsigned char* lds, int tok0, int h, int qb, float lam, int kt_lo, int kt_hi, float km0, float km1) {
    const int tid = threadIdx.x, lane = tid & 63, w = tid >> 6, r32 = lane & 31, hi = lane >> 5;
    const int map = w & 1, qs = w >> 1;
    const bf16_t* QKV = (const bf16_t*)(a.ws + WS_R1);
    const int q0 = qb * 128 + qs * 32;
    const size_t qtok = (size_t)(tok0 + q0 + r32);
    bf16x8 qf[4];
#pragma unroll
    for (int d0 = 0; d0 < 4; ++d0) qf[d0] = *(const bf16x8*)(QKV + qtok * 3072 + h * 128 + map * 64 + 16 * d0 + 8 * hi);
    float qn2 = 0.f;
#pragma unroll
    for (int d0 = 0; d0 < 4; ++d0) { const u32x4 qw = __builtin_bit_cast(u32x4, qf[d0]);
#pragma unroll
        for (int e = 0; e < 4; ++e) { const float x0 = bf_lo(qw[e]), x1 = bf_hi(qw[e]); qn2 += x0 * x0 + x1 * x1; } }
    qn2 += __shfl_xor(qn2, 32);
    const float mref = fminf(sqrtf(qn2) * (map ? km1 : km0) * 1.01f, 40.f);
    asm volatile("" : "+v"(qf[0]), "+v"(qf[1]), "+v"(qf[2]), "+v"(qf[3]));
    const float slope2 = ex2(-(float)(h + 1)) * LOG2E;
    const int lk0 = tid >> 4, lch = tid & 15;
    const bf16_t* kg = QKV + (size_t)(tok0 + kt_lo * 64 + lk0) * 3072 + 1024 + h * 128 + lch * 8;
    const bf16_t* vg = kg + 1024;
    u32x4 kr0 = *(const u32x4*)kg, kr1 = *(const u32x4*)(kg + (size_t)32 * 3072), vr0 = *(const u32x4*)vg, vr1 = *(const u32x4*)(vg + (size_t)32 * 3072);
    LAS unsigned char* stK = lds + lk0 * 272 + lch * 16;
    LAS unsigned char* stV = lds + AT_KB + lk0 * 320 + lch * 16;
    *(LAS u32x4*)stK = kr0; *(LAS u32x4*)(stK + 32 * 272) = kr1; *(LAS u32x4*)stV = vr0; *(LAS u32x4*)(stV + 32 * 320) = vr1;
    __syncthreads();
    f32x16 o[4];
#pragma unroll
    for (int dt = 0; dt < 4; ++dt)
#pragma unroll
        for (int r = 0; r < 16; ++r) o[dt][r] = 0.f;
    float l = 0.f;
    const int i16 = lane & 15, qq = i16 >> 2, p = i16 & 3, g2 = (lane >> 4) & 1;
    for (int kt = kt_lo; kt <= kt_hi; ++kt) {
        const int buf = (kt - kt_lo) & 1;
        if (kt < kt_hi) {
            const size_t off = (size_t)(kt + 1 - kt_lo) * 64 * 3072;
            kr0 = *(const u32x4*)(kg + off); kr1 = *(const u32x4*)(kg + off + (size_t)32 * 3072); vr0 = *(const u32x4*)(vg + off); vr1 = *(const u32x4*)(vg + off + (size_t)32 * 3072);
        }
        LAS const unsigned char* kb = lds + buf * AT_BUF + r32 * 272 + (map * 64 + 8 * hi) * 2;
        f32x16 p0, p1;
        const int kbase = kt * 64;
        const float dbase = (float)(q0 + r32 - kbase - 4 * hi);
        if (kbase > q0 + 31 || kbase + 63 < q0) {
            const float cf_ = (kbase > q0 + 31) ? -slope2 : slope2;
            const float lt = -cf_ * dbase - mref;
#pragma unroll
            for (int r = 0; r < 16; ++r) { const float cc = (float)((r & 3) + 8 * (r >> 2)); p0[r] = cf_ * cc + lt; p1[r] = cf_ * (cc + 32.f) + lt; }
        } else {
#pragma unroll
            for (int r = 0; r < 16; ++r) { const float cc = (float)((r & 3) + 8 * (r >> 2)); p0[r] = -slope2 * __builtin_fabsf(dbase - cc) - mref; p1[r] = -slope2 * __builtin_fabsf(dbase - cc - 32.f) - mref; }
        }
        bf16x8 ka[4], kc[4];
#pragma unroll
        for (int d0 = 0; d0 < 4; ++d0) { ka[d0] = *(LAS const bf16x8*)(kb + d0 * 32); kc[d0] = *(LAS const bf16x8*)(kb + 32 * 272 + d0 * 32); }
        LAS const unsigned char* vbp = lds + buf * AT_BUF + AT_KB + (4 * hi + qq) * 320 + (16 * g2 + 4 * p) * 2;
        s16x4 vl0[4], vh0[4];
#pragma unroll
        for (int dt = 0; dt < 4; ++dt) { vl0[dt] = vtr(vbp + dt * 64); vh0[dt] = vtr(vbp + 8 * 320 + dt * 64); }
        __builtin_amdgcn_sched_barrier(0);
#pragma unroll
        for (int d0 = 0; d0 < 4; ++d0) p0 = mfma32(ka[d0], qf[d0], p0);
#pragma unroll
        for (int d0 = 0; d0 < 4; ++d0) p1 = mfma32(kc[d0], qf[d0], p1);
        bf16x8 pf[4];
        float ls = 0.f;
#pragma unroll
        for (int r = 0; r < 16; ++r) { p0[r] = ex2(p0[r]); ls += p0[r]; }
#pragma unroll
        for (int s = 0; s < 2; ++s) { u32x4 t0;
#pragma unroll
            for (int e = 0; e < 4; ++e) t0[e] = cvtpk(p0[8 * s + 2 * e], p0[8 * s + 2 * e + 1]);
            pf[s] = __builtin_bit_cast(bf16x8, t0); }
#pragma unroll
        for (int dt = 0; dt < 4; ++dt) o[dt] = mfma32(cat8(vl0[dt], vh0[dt]), pf[0], o[dt]);
#pragma unroll
        for (int dt = 0; dt < 4; ++dt) { const s16x4 lo = vtr(vbp + 16 * 320 + dt * 64), hh = vtr(vbp + (16 + 8) * 320 + dt * 64); o[dt] = mfma32(cat8(lo, hh), pf[1], o[dt]); }
#pragma unroll
        for (int r = 0; r < 16; ++r) { p1[r] = ex2(p1[r]); ls += p1[r]; }
#pragma unroll
        for (int s = 0; s < 2; ++s) { u32x4 t1;
#pragma unroll
            for (int e = 0; e < 4; ++e) t1[e] = cvtpk(p1[8 * s + 2 * e], p1[8 * s + 2 * e + 1]);
            pf[2 + s] = __builtin_bit_cast(bf16x8, t1); }
#pragma unroll
        for (int s = 2; s < 4; ++s)
#pragma unroll
            for (int dt = 0; dt < 4; ++dt) { const s16x4 lo = vtr(vbp + (16 * s) * 320 + dt * 64), hh = vtr(vbp + (16 * s + 8) * 320 + dt * 64); o[dt] = mfma32(cat8(lo, hh), pf[s], o[dt]); }
        l += ls;
        if (kt < kt_hi) {
            LAS unsigned char* dK = stK + (buf ^ 1) * AT_BUF; LAS unsigned char* dV = stV + (buf ^ 1) * AT_BUF;
            *(LAS u32x4*)dK = kr0; *(LAS u32x4*)(dK + 32 * 272) = kr1; *(LAS u32x4*)dV = vr0; *(LAS u32x4*)(dV + 32 * 320) = vr1;
        }
        __syncthreads();
    }
    l += __shfl_xor(l, 32);
    const float inv = 1.f / l;
    LAS float* X = (LAS float*)lds + qs * 4096;
    if (map == 1) {
        const float f = lam * inv;
#pragma unroll
        for (int dt = 0; dt < 4; ++dt)
#pragma unroll
            for (int r = 0; r < 16; ++r) X[(dt * 16 + r) * 64 + lane] = o[dt][r] * f;
    }
    __syncthreads();
    if (map == 0) {
        float ss = 0.f;
#pragma unroll
        for (int dt = 0; dt < 4; ++dt)
#pragma unroll
            for (int r = 0; r < 16; ++r) { const float v = o[dt][r] * inv - X[(dt * 16 + r) * 64 + lane]; o[dt][r] = v; ss += v * v; }
        ss += __shfl_xor(ss, 32);
        const float rs = rsqrtf(ss * (1.f / 128.f) + LN_EPS) * (1.f - LAM_INIT);
        bf16_t* O1 = (bf16_t*)((unsigned char*)a.out + OUT_B) + qtok * 1024 + h * 128;
        const float* sg = a.in[21];
#pragma unroll
        for (int dt = 0; dt < 4; ++dt)
#pragma unroll
            for (int rq = 0; rq < 4; ++rq) {
                const int dh = 32 * dt + 8 * rq + 4 * hi; const f32x4 gg = *(const f32x4*)(sg + dh);
                u32x2 wv; wv[0] = cvtpk(o[dt][4 * rq] * rs * gg[0], o[dt][4 * rq + 1] * rs * gg[1]); wv[1] = cvtpk(o[dt][4 * rq + 2] * rs * gg[2], o[dt][4 * rq + 3] * rs * gg[3]);
                *(u32x2*)(O1 + dh) = wv;
            }
    }
    __syncthreads();
}

DI float wave_sum64(float v) {
#pragma unroll
    for (int o = 1; o < 64; o <<= 1) v += __shfl_xor(v, o);
    return v;
}

#define XB_TMO      128
#define XB_XCNT(j)  (256  + 64 * (j))
#define XB_XSUB(j)  (1280 + 64 * (j))
#define XB_XGEN(j)  (2304 + 64 * (j))
#define XB_TOP      3328
#define XB_TOPGEN   3392
#define XCD_BAR_WORDS 3456
#define XB_SPIN_CAP (1u << 22)

__device__ __forceinline__ unsigned xb_ld(unsigned* p)              { return __hip_atomic_load(p, __ATOMIC_RELAXED, __HIP_MEMORY_SCOPE_AGENT); }
__device__ __forceinline__ unsigned xb_add(unsigned* p, unsigned v) { return __hip_atomic_fetch_add(p, v, __ATOMIC_RELAXED, __HIP_MEMORY_SCOPE_AGENT); }
__device__ __forceinline__ unsigned xb_xcc_id() { return (unsigned)__builtin_amdgcn_s_getreg((3 << 11) | 20) & 0xFu; }
#define XB_SPIN(cond, bar) do { unsigned _sp = 0; while (cond) { __builtin_amdgcn_s_sleep(1); \
    if ((++_sp & 255u) == 0u) { if (xb_ld(&(bar)[XB_TMO])) break; if (_sp > XB_SPIN_CAP) { atomicAdd(&(bar)[XB_TMO], 1u); break; } } } } while (0)

struct XcdBarrier {
    unsigned* bar; unsigned x;
    volatile LAS unsigned* st;
};

__device__ __forceinline__ XcdBarrier xcd_barrier_post(unsigned* bar, volatile LAS unsigned* st) {
    XcdBarrier b; b.bar = bar; b.x = xb_xcc_id(); b.st = st;
    if (threadIdx.x == 0) (void)xb_add(&bar[XB_XCNT(b.x)], 1u);
    return b;
}
__device__ __forceinline__ void xcd_barrier_complete(unsigned* bar, unsigned x, unsigned& nloc, unsigned& nx) {
    const unsigned G = gridDim.x * gridDim.y * gridDim.z;
    unsigned sum, cnt, mine, sp = 0u;
    for (;;) {
        sum = 0u; cnt = 0u; mine = 0u;
#pragma unroll
        for (unsigned j = 0; j < 16; ++j) { const unsigned c = xb_ld(&bar[XB_XCNT(j)]); sum += c; cnt += (c > 0u) ? 1u : 0u; mine = (j == x) ? c : mine; }
        if (sum == G) break;
        __builtin_amdgcn_s_sleep(1);
        if ((++sp & 255u) == 0u) { if (xb_ld(&bar[XB_TMO])) break; if (sp > XB_SPIN_CAP) { atomicAdd(&bar[XB_TMO], 1u); break; } }
    }
    nloc = mine > 0u ? mine : 1u; nx = cnt > 0u ? cnt : 1u;
}

__device__ __forceinline__ void xcd_barrier(const XcdBarrier& b) {
    asm volatile("s_waitcnt vmcnt(0)" ::: "memory");
    __syncthreads();
    if (threadIdx.x == 0) {
        unsigned* bar = b.bar;
        __builtin_amdgcn_s_waitcnt(0);
        unsigned nloc = b.st[0], nx = b.st[1];
        if (nloc == 0u) { xcd_barrier_complete(bar, b.x, nloc, nx); b.st[0] = nloc; b.st[1] = nx; }
        const unsigned old = xb_add(&bar[XB_XSUB(b.x)], 1u);
        const unsigned gen = old / nloc;
        if (old + 1u == (gen + 1u) * nloc) {
            __builtin_amdgcn_fence(__ATOMIC_RELEASE, "agent");
            asm volatile("s_waitcnt vmcnt(0)" ::: "memory");
            const unsigned og = xb_add(&bar[XB_TOP], 1u);
            const unsigned tg = og / nx;
            if (og + 1u == (tg + 1u) * nx) xb_add(&bar[XB_TOPGEN], 1u);
            else XB_SPIN(xb_ld(&bar[XB_TOPGEN]) == tg, bar);
            __builtin_amdgcn_fence(__ATOMIC_ACQUIRE, "agent");
            xb_add(&bar[XB_XGEN(b.x)], 1u);
            asm volatile("s_waitcnt vmcnt(0)" ::: "memory");
        } else {
            XB_SPIN(xb_ld(&bar[XB_XGEN(b.x)]) == gen, bar);
            __builtin_amdgcn_fence(__ATOMIC_ACQUIRE, "agent");
            asm volatile("s_waitcnt vmcnt(0)" ::: "memory");
        }
    }
    __syncthreads();
}

__global__ void __launch_bounds__(512, 2) mk_fwd(Args a) {
    extern __shared__ __attribute__((aligned(16))) unsigned char lds_raw[];
    LAS unsigned char* lds = (LAS unsigned char*)lds_raw;
    const int G = gridDim.x, bx = blockIdx.x, tid = threadIdx.x;
    unsigned char* ws = a.ws; unsigned char* ob = (unsigned char*)a.out;
#ifndef PHMASK
#define PHMASK 0xFFFF
#endif
#define IN(k) (((PHMASK >> ((k) & 15)) & 1) && a.ph_lo <= (k) && (k) < a.ph_hi)
#ifndef REPMASK
#define REPMASK 0
#endif
#define REP(k) for (int rep_ = 0; rep_ <= ((REPMASK >> ((k) & 15)) & 1); ++rep_)
#define RSYNC() do { if (rep_) xcd_barrier(bar); } while (0)
#define SEAM(k) do { if (a.ph_lo <= (k) && (k) + 1 < a.ph_hi) xcd_barrier(bar); } while (0)
    float* cf = (float*)(ws + WS_CF);
    if (tid < 16) ((LAS unsigned*)(lds + LDS_BYTES - 64))[tid] = 0u;
    __syncthreads();
    XcdBarrier bar; bar.bar = (unsigned*)(ws + WS_CTL); bar.x = 0; bar.st = (volatile LAS unsigned*)(lds + LDS_BYTES - 64);
    if (a.ph_hi - a.ph_lo > 1) bar = xcd_barrier_post((unsigned*)(ws + WS_CTL), (volatile LAS unsigned*)(lds + LDS_BYTES - 64));
    if (a.ph_hi < 0) cg::this_grid().sync();
    float* stA = (float*)(ws + WS_STA); float* stB = (float*)(ws + WS_STB);

    if (IN(0)) REP(0) { RSYNC(); phase_prologue(a, lds, bx, G); }
    SEAM(0);
    if (IN(1)) REP(1) { RSYNC();
        fold_finalize(a, bx, G);
        pg8::Gemm g{(const bf16_t*)(ob + OUT_A), (const bf16_t*)(ws + WS_WIN0), M, 2560, 1024}; pg8::StaticOrder S; S.init(M, 2560, G, bx);
        EpiIn0 E{(bf16_t*)(ws + WS_R1), (bf16_t*)(ws + WS_R2), (float*)(ws + WS_VST)};
        pg8::gemm_phase<EpiIn0, pg8::StaticOrder, true, true>(lds, g, S, E);
    }
    SEAM(1);
    if (IN(2)) REP(2) { RSYNC();
        for (int u = bx; u < 2048; u += G) na_unit(a, lds, u);
        for (int u = bx; u < 1024; u += G) gate_unit(a, lds, u);
    }
    SEAM(2);
    if (IN(3)) REP(3) { RSYNC();
        pg8::Gemm g{(const bf16_t*)(ob + OUT_B), (const bf16_t*)(ws + WS_WOUT0), M, 1024, 1024}; pg8::StaticOrder S; S.init(M, 1024, G, bx);
        EpiRes<0, false> E{a.in[0], a.in[1], nullptr, nullptr, nullptr, nullptr, (bf16_t*)(ws + WS_R1), stA, nullptr, 0};
        pg8::gemm_phase<EpiRes<0, false>, pg8::StaticOrder, true, true>(lds, g, S, E);
    }
    SEAM(3);
#pragma unroll 1
    for (int half = 0; half < 2; ++half) {
        const int p1 = 4 + 2 * half, p2 = 5 + 2 * half, ro = half * MH;
        if (IN(p1)) REP(p1) { RSYNC();
            pg8::Gemm g{(const bf16_t*)(ws + WS_R1) + (size_t)ro * 1024, (const bf16_t*)(ws + WS_WFF1_0), MH, 4096, 1024}; pg8::StaticOrder S; S.init(MH, 4096, G, bx);
            EpiFold<0> E{stA, cf + 0 * 4096, cf + 1 * 4096, (bf16_t*)(ws + WS_R2), 4096, ro, nullptr};
            pg8::gemm_phase<EpiFold<0>, pg8::StaticOrder, true, true>(lds, g, S, E);
        }
        SEAM(p1);
        if (IN(p2)) REP(p2) { RSYNC();
            pg8::Gemm g{(const bf16_t*)(ws + WS_R2), (const bf16_t*)(ws + WS_WFF2_0), MH, 1024, 4096}; pg8::StaticOrder S; S.init(MH, 1024, G, bx);
            EpiRes<1, false> E{nullptr, nullptr, (const bf16_t*)(ws + WS_R1), stA, a.in[9], a.in[10], (bf16_t*)(ob + OUT_A), stB, nullptr, ro};
            pg8::gemm_phase<EpiRes<1, false>, pg8::StaticOrder, true, true>(lds, g, S, E);
        }
        SEAM(p2);
    }
    if (IN(8)) REP(8) { RSYNC();
        pg8::Gemm g{(const bf16_t*)(ob + OUT_A), (const bf16_t*)(ws + WS_WIN1), M, 3072, 1024}; pg8::StaticOrder S; S.init(M, 3072, G, bx);
        EpiFold<1> E{stB, cf + 2 * 4096, cf + 3 * 4096, (bf16_t*)(ws + WS_R1), 3072, 0, (unsigned*)(ws + WS_NRM)};
        pg8::gemm_phase<EpiFold<1>, pg8::StaticOrder, true, true>(lds, g, S, E);
    }
    SEAM(8);
    if (IN(9)) REP(9) { RSYNC();
        const int lane = tid & 63;
        const float d1 = wave_sum64(a.in[17][lane] * a.in[18][lane]), d2 = wave_sum64(a.in[19][lane] * a.in[20][lane]);
        const float lam = __expf(d1) - __expf(d2) + LAM_INIT;
        const unsigned* nrm = (const unsigned*)(ws + WS_NRM);
        unsigned* qheads = (unsigned*)(ws + WS_CTL) + 4096;
        LAS unsigned* qslot = (LAS unsigned*)(lds + LDS_BYTES - 32);
        for (int jq = 0; jq < 8; ++jq) {
          const int x = (bx + jq) & 7, pi = x & 3, b0 = 2 * (x >> 2);
          for (;;) {
            if (tid == 0) *qslot = atomicAdd(qheads + 64 * x, 1u);
            __syncthreads();
            const int idx = (int)*qslot;
            __syncthreads();
            if (idx >= 256) break;
            int tok0, T, h, qb, seq, i2, nqb;
            if (idx < 32) { seq = b0; h = 7 - pi; i2 = idx; nqb = 32; }
            else if (idx < 64) { seq = b0 + 1; h = 4 + pi; i2 = idx - 32; nqb = 32; }
            else if (idx < 128) { seq = 4 + x; h = 7 - ((idx - 64) >> 4); i2 = (idx - 64) & 15; nqb = 16; }
            else if (idx < 160) { seq = b0 + 1; h = 3 - pi; i2 = idx - 128; nqb = 32; }
            else if (idx < 192) { seq = 4 + x; h = 3 - ((idx - 160) >> 4); i2 = (idx - 160) & 15; nqb = 16; }
            else if (idx < 224) { seq = b0; h = pi; i2 = idx - 192; nqb = 32; }
            else { seq = 4 + x; h = 1 - ((idx - 224) >> 4); i2 = (idx - 224) & 15; nqb = 16; }
            qb = (i2 & 1) ? (nqb / 2 - 1 - (i2 >> 1)) : (nqb / 2 + (i2 >> 1));
            if (nqb == 32) { tok0 = seq * 4096; T = 4096; } else { tok0 = MH + (seq - 4) * 2048; T = 2048; }
            const unsigned* nr = nrm + seq * 64 + h * 4;
            float B = 0.f, km[2];
#pragma unroll
            for (int mp = 0; mp < 2; ++mp) {
                const float Q2 = __uint_as_float(nr[mp * 2]) + __uint_as_float(nr[mp * 2 + 1]), K2 = __uint_as_float(nr[32 + mp * 2]) + __uint_as_float(nr[32 + mp * 2 + 1]);
                B = fmaxf(B, 2.04f * sqrtf(Q2 * K2)); km[mp] = sqrtf(K2);
            }
            const float dskip = (64.f + B) / (ex2(-(float)(h + 1)) * LOG2E);
            const int NT = T / 64; int kt_lo = 0, kt_hi = NT - 1;
            if (dskip < 1.0e6f) {
                kt_lo = max(0, (int)floorf(((float)(qb * 128) - dskip - 63.f) * (1.f / 64.f)));
                kt_hi = min(NT - 1, (int)ceilf(((float)(qb * 128 + 127) + dskip) * (1.f / 64.f)));
            }
            attn_unit(a, lds, tok0, h, qb, lam, kt_lo, kt_hi, km[0], km[1]);
          }
        }
    }
    SEAM(9);
    if (IN(10)) REP(10) { RSYNC();
        pg8::Gemm g{(const bf16_t*)(ob + OUT_B), (const bf16_t*)(ws + WS_WOUT1), M, 1024, 1024}; pg8::StaticOrder S; S.init(M, 1024, G, bx);
        EpiRes<1, false> E{nullptr, nullptr, (const bf16_t*)(ob + OUT_A), stB, a.in[13], a.in[14], (bf16_t*)(ws + WS_R1), stA, nullptr, 0};
        pg8::gemm_phase<EpiRes<1, false>, pg8::StaticOrder, true, true>(lds, g, S, E);
    }
    SEAM(10);
#pragma unroll 1
    for (int half = 0; half < 2; ++half) {
        const int p1 = 11 + 2 * half, p2 = 12 + 2 * half, ro = half * MH;
        if (IN(p1)) REP(p1) { RSYNC();
            pg8::Gemm g{(const bf16_t*)(ws + WS_R1) + (size_t)ro * 1024, (const bf16_t*)(ws + WS_WFF1_1), MH, 4096, 1024}; pg8::StaticOrder S; S.init(MH, 4096, G, bx);
            EpiFold<0> E{stA, cf + 4 * 4096, cf + 5 * 4096, (bf16_t*)(ws + WS_R2), 4096, ro, nullptr};
            pg8::gemm_phase<EpiFold<0>, pg8::StaticOrder, true, true>(lds, g, S, E);
        }
        SEAM(p1);
        if (IN(p2)) REP(p2) { RSYNC();
            pg8::Gemm g{(const bf16_t*)(ws + WS_R2), (const bf16_t*)(ws + WS_WFF2_1), MH, 1024, 4096}; pg8::StaticOrder S; S.init(MH, 1024, G, bx);
            EpiRes<1, true> E{nullptr, nullptr, (const bf16_t*)(ws + WS_R1), stA, a.in[22], a.in[23], nullptr, nullptr, a.out, ro};
            pg8::gemm_phase<EpiRes<1, true>, pg8::StaticOrder, true, true>(lds, g, S, E);
        }
        SEAM(p2);
    }
#ifdef EXTRA_SYNCS
    for (int es_ = 0; es_ < EXTRA_SYNCS; ++es_) xcd_barrier(bar);
#endif
    if (IN(15)) {
        const int lane = tid & 63, gw = bx * 8 + (tid >> 6), NGW = G * 8;
        const f32x4* gp = (const f32x4*)a.in[26]; const f32x4* bp = (const f32x4*)a.in[27];
        for (int m = gw; m < M; m += NGW) {
            f32x4* row = (f32x4*)(a.out + (size_t)m * 1024);
            f32x4 v[4]; float s = 0.f;
#pragma unroll
            for (int j = 0; j < 4; ++j) { v[j] = row[lane + 64 * j]; s += (v[j][0] + v[j][1]) + (v[j][2] + v[j][3]); }
            const float mean = wave_sum64(s) * (1.f / 1024.f); float s2 = 0.f;
#pragma unroll
            for (int j = 0; j < 4; ++j) { v[j] = v[j] - mean; s2 += (v[j][0] * v[j][0] + v[j][1] * v[j][1]) + (v[j][2] * v[j][2] + v[j][3] * v[j][3]); }
            const float rstd = rsqrtf(wave_sum64(s2) * (1.f / 1024.f) + LN_EPS);
#pragma unroll
            for (int j = 0; j < 4; ++j) row[lane + 64 * j] = v[j] * rstd * gp[lane + 64 * j] + bp[lane + 64 * j];
        }
    }
#undef IN
#undef SEAM
}

#ifndef MK_PER_PHASE
#define MK_PER_PHASE 0
#endif
extern "C" void kernel_launch(void* const* d_in, const int* in_sizes, int n_in, void* d_out, int out_size, void* d_ws, size_t ws_size, hipStream_t stream) {
    static int grid = 0;
    if (grid == 0) {
        if (n_in != 28 || out_size != M * DM || ws_size < WS_END) { fprintf(stderr, "kernel_launch: unexpected shapes (n_in %d out %d ws %zu)\n", n_in, out_size, ws_size); grid = -1; return; }
        int dev = 0, cus = 0, per_cu = 0;
        (void)hipGetDevice(&dev);
        (void)hipDeviceGetAttribute(&cus, hipDeviceAttributeMultiprocessorCount, dev);
        if (hipFuncSetAttribute((const void*)mk_fwd, hipFuncAttributeMaxDynamicSharedMemorySize, LDS_BYTES) != hipSuccess) { fprintf(stderr, "kernel_launch: hipFuncSetAttribute failed\n"); }
        if (hipOccupancyMaxActiveBlocksPerMultiprocessor(&per_cu, (const void*)mk_fwd, 512, LDS_BYTES) != hipSuccess || per_cu < 1) per_cu = 1;
        (void)hipGetLastError();
        if (cus <= 0) cus = 256;
        grid = cus * per_cu;
    }
    if (grid < 0) return;
    Args a{};
    for (int i = 0; i < 28; ++i) a.in[i] = (const float*)d_in[i];
    a.out = (float*)d_out; a.ws = (unsigned char*)d_ws;
#if MK_PER_PHASE
    for (int p = 0; p < NPHASE; ++p) { a.ph_lo = p; a.ph_hi = p + 1; hipLaunchKernelGGL(mk_fwd, dim3(grid), dim3(512), LDS_BYTES, stream, a); }
#else
    a.ph_lo = 0; a.ph_hi = NPHASE;
    (void)hipMemsetAsync((unsigned char*)d_ws + WS_CTL, 0, 32768, stream);
    void* args[] = {&a};
    hipError_t e = hipLaunchCooperativeKernel((const void*)mk_fwd, dim3(grid), dim3(512), args, LDS_BYTES, stream);
    if (e != hipSuccess) fprintf(stderr, "cooperative launch failed: %s (grid %d)\n", hipGetErrorString(e), grid);
#endif
}
```

```cpp
#include <hip/hip_runtime.h>
#include <hip/hip_cooperative_groups.h>
#include <cstdio>
#include <cstdint>
namespace cg = cooperative_groups;
namespace pg8 {
#define PG8_LAS __attribute__((address_space(3)))
typedef unsigned short bf16_t;
typedef short bf16x8 __attribute__((ext_vector_type(8)));
typedef float f32x4 __attribute__((ext_vector_type(4)));
typedef unsigned u32x4 __attribute__((ext_vector_type(4)));
constexpr int BM = 256, BK = 64, HALF = 128, HTB = HALF * BK * 2  , STAGE_BYTES = 8 * HTB, NXCD = 8, WGM = 8;

__host__ __device__ __forceinline__ int lds_byte(int r, int c) { const int st = (r >> 4) * 2 + (c >> 5), rr = r & 15, cc = c & 31, ob = rr * 64 + cc * 2; return st * 1024 + (ob ^ (((ob >> 9) & 1) << 5)); }
__host__ __device__ __forceinline__ void stage_rc(int b, int& R, int& C) { const int st = b / 1024, sb = b % 1024, swz = sb ^ (((sb >> 9) & 1) << 5); R = (st >> 1) * 16 + swz / 64; C = (st & 1) * 32 + (swz % 64) / 2; }
__host__ __device__ __forceinline__ int perm32(int rho) { const int n = rho >> 4, i = rho & 15; return 8 * (i >> 2) + 4 * n + (i & 3); }

struct Unit { int pm, pn; };
struct Gemm { const bf16_t* A; const bf16_t* Bt; int M, N, K; };

struct StaticOrder {
    int nM, nN, nwg, G, c;
    __host__ __device__ void init(int M, int N, int G_, int c_) { nM = M / BM; nN = N / BM; nwg = nM * nN; G = G_; c = c_; }
    __host__ __device__ bool next(int i, Unit& u) const {
        const long L = (long)i * G + c; if (L >= nwg) return false;
        int wgid = (int)L; { const int q = nwg / NXCD, r = nwg % NXCD, xcd = wgid % NXCD, off = wgid / NXCD; wgid = (xcd < r ? xcd * (q + 1) : r * (q + 1) + (xcd - r) * q) + off; }
        const int nig = WGM * nN, gid = wgid / nig, fm = gid * WGM, gsz = (nM - fm) < WGM ? (nM - fm) : WGM;
        u.pm = fm + ((wgid % nig) % gsz); u.pn = (wgid % nig) / gsz; return true;
    }
    __device__ __forceinline__ void a_ready(const Unit&) const {}
    __device__ __forceinline__ void done(const Unit&) const {}
};

template <class Epi, class Sched, bool ALIGN_EPI = false, bool SP2 = false>
__device__ __forceinline__ void gemm_phase(PG8_LAS unsigned char* lds, const Gemm g, const Sched& S, const Epi& E) {
    int tid_o = threadIdx.x; asm volatile("" : "+v"(tid_o)); const int tid = tid_o, wid = __builtin_amdgcn_readfirstlane(tid >> 6), lane = tid & 63, wr = wid >> 2, wc = wid & 3, fr = lane & 15, fq = lane >> 4;
    const int K = g.K, nt = K / BK;
    unsigned voffA[2], voffB[2];
#pragma unroll
    for (int i = 0; i < 2; ++i) { int R, C; stage_rc(tid * 16 + i * 8192, R, C); const int Rb = Epi::PERM ? ((R & ~31) + perm32(R & 31)) : R;
        voffA[i] = (unsigned)(R * K + C) * 2u; voffB[i] = (unsigned)(Rb * K + C) * 2u; }
    const size_t kstep = (size_t)(BK * 2);
    const size_t hstep = (size_t)HALF * K * 2;
    const size_t tstep = 2 * hstep;
    const unsigned ldsw = (unsigned)wid * 1024u;
    const int aoff = lds_byte(wr * 64 + fr, fq * 8), boff = lds_byte(wc * 32 + fr, fq * 8);
#define PG8_SA(b, h) (((b) * 2 + (h)) * HTB)
#define PG8_SB(b, h) ((4 + (b) * 2 + (h)) * HTB)
#define PG8_STAGE(bufoff, gbase, voff) do { _Pragma("unroll") for (int _i = 0; _i < 2; ++_i) \
        __builtin_amdgcn_global_load_lds((const unsigned*)((const char*)(gbase) + (voff)[_i]), (PG8_LAS unsigned*)(lds + (bufoff) + ldsw + _i * 8192), 16, 0, 0); } while (0)
#define PG8_LDA(dst, b, h) do { _Pragma("unroll") for (int m = 0; m < 4; ++m) _Pragma("unroll") for (int k = 0; k < 2; ++k) dst[m][k] = *(const PG8_LAS bf16x8*)(lds + PG8_SA(b, h) + aoff + m * 2048 + k * 1024); } while (0)
#define PG8_LDB(dst, b, h) do { _Pragma("unroll") for (int n = 0; n < 2; ++n) _Pragma("unroll") for (int k = 0; k < 2; ++k) dst[n][k] = *(const PG8_LAS bf16x8*)(lds + PG8_SB(b, h) + boff + n * 2048 + k * 1024); } while (0)
#define PG8_MMA(ai, bj, At, Bt) do { __builtin_amdgcn_s_setprio(1); _Pragma("unroll") for (int m = 0; m < 4; ++m) _Pragma("unroll") for (int n = 0; n < 2; ++n) _Pragma("unroll") for (int k = 0; k < 2; ++k) \
        acc[ai][bj][m][n] = __builtin_amdgcn_mfma_f32_16x16x32_bf16(Bt[n][k], At[m][k], acc[ai][bj][m][n], 0, 0, 0); __builtin_amdgcn_s_setprio(0); } while (0)
#define PG8_WAIT_V(n) asm volatile("s_waitcnt vmcnt(" #n ")" ::: "memory")
#define PG8_WAIT_L(n) asm volatile("s_waitcnt lgkmcnt(" #n ")" ::: "memory")
#define PG8_BAR __builtin_amdgcn_s_barrier()
#define PG8_SCHED __builtin_amdgcn_sched_barrier(0)
    Unit cur, nxt; int ui = 0;
    if (!S.next(0, cur)) return;
    f32x4 acc[2][2][4][2];
#pragma unroll
    for (int a = 0; a < 2; ++a)
#pragma unroll
        for (int b = 0; b < 2; ++b)
#pragma unroll
            for (int m = 0; m < 4; ++m)
#pragma unroll
                for (int n = 0; n < 2; ++n) acc[a][b][m][n] = (f32x4){0.f, 0.f, 0.f, 0.f};
    bf16x8 At[4][2], B0[2][2], B1[2][2];
    const char* cA = (const char*)g.A + (size_t)cur.pm * tstep; const char* cB = (const char*)g.Bt + (size_t)cur.pn * tstep;
    S.a_ready(cur);
    if constexpr (SP2) {
        PG8_STAGE(PG8_SB(0, 0), cB, voffB); PG8_STAGE(PG8_SB(0, 1), cB + hstep, voffB); PG8_STAGE(PG8_SA(0, 0), cA, voffA); PG8_STAGE(PG8_SA(0, 1), cA + hstep, voffA);
        if (wr == 1) PG8_BAR;
        PG8_WAIT_V(2); PG8_BAR;
        PG8_STAGE(PG8_SB(1, 0), cB + kstep, voffB); PG8_STAGE(PG8_SA(1, 0), cA + kstep, voffA); PG8_STAGE(PG8_SB(1, 1), cB + hstep + kstep, voffB);
        PG8_WAIT_V(6); PG8_BAR;
    } else {
        PG8_STAGE(PG8_SB(0, 0), cB, voffB); PG8_STAGE(PG8_SA(0, 0), cA, voffA); PG8_STAGE(PG8_SB(0, 1), cB + hstep, voffB); PG8_STAGE(PG8_SA(0, 1), cA + hstep, voffA);
        if (wr == 1) PG8_BAR;
        PG8_WAIT_V(4); PG8_BAR;
        PG8_STAGE(PG8_SB(1, 0), cB + kstep, voffB); PG8_STAGE(PG8_SA(1, 0), cA + kstep, voffA); PG8_STAGE(PG8_SB(1, 1), cB + hstep + kstep, voffB);
        PG8_WAIT_V(6); PG8_BAR;
    }
    for (;;) {
        const bool has_next = S.next(ui + 1, nxt);
        const char* nA = has_next ? (const char*)g.A + (size_t)nxt.pm * tstep : cA; const char* nB = has_next ? (const char*)g.Bt + (size_t)nxt.pn * tstep : cB;
        for (int t = 0; t < nt; t += 2) {
            const bool last = (t == nt - 2);
            const char* a1 = cA + (size_t)(t + 1) * kstep;
            const char* a2 = last ? nA : cA + (size_t)(t + 2) * kstep; const char* b2 = last ? nB : cB + (size_t)(t + 2) * kstep;
            const char* a3 = a2 + kstep; const char* b3 = b2 + kstep;
            if (last && has_next) S.a_ready(nxt);
            if constexpr (SP2) {
            PG8_LDB(B0, 0, 0); PG8_LDB(B1, 0, 1); PG8_SCHED; PG8_LDA(At, 0, 0); PG8_STAGE(PG8_SA(1, 1), a1 + hstep, voffA);
            PG8_WAIT_V(8); PG8_WAIT_L(0); PG8_BAR; PG8_MMA(0, 0, At, B0); PG8_MMA(0, 1, At, B1); PG8_BAR; PG8_SCHED;
            PG8_LDA(At, 0, 1); PG8_STAGE(PG8_SB(0, 0), b2, voffB); PG8_STAGE(PG8_SB(0, 1), b2 + hstep, voffB); PG8_STAGE(PG8_SA(0, 0), a2, voffA);
            PG8_WAIT_V(8); PG8_WAIT_L(0); PG8_BAR; PG8_MMA(1, 0, At, B0); PG8_MMA(1, 1, At, B1); PG8_BAR; PG8_SCHED;
            PG8_LDB(B0, 1, 0); PG8_LDB(B1, 1, 1); PG8_SCHED; PG8_LDA(At, 1, 0); PG8_STAGE(PG8_SA(0, 1), a2 + hstep, voffA);
            PG8_WAIT_V(8); PG8_WAIT_L(0); PG8_BAR; PG8_MMA(0, 0, At, B0); PG8_MMA(0, 1, At, B1); PG8_BAR; PG8_SCHED;
            PG8_LDA(At, 1, 1); PG8_STAGE(PG8_SB(1, 0), b3, voffB); PG8_STAGE(PG8_SB(1, 1), b3 + hstep, voffB); PG8_STAGE(PG8_SA(1, 0), a3, voffA);
            PG8_WAIT_V(8); PG8_WAIT_L(0); PG8_BAR; PG8_MMA(1, 0, At, B0); PG8_MMA(1, 1, At, B1); PG8_BAR; PG8_SCHED;
            } else {
            PG8_LDB(B0, 0, 0); PG8_SCHED; PG8_LDA(At, 0, 0); PG8_STAGE(PG8_SA(1, 1), a1 + hstep, voffA);
            PG8_WAIT_L(8); PG8_BAR; PG8_WAIT_L(0); PG8_MMA(0, 0, At, B0); PG8_BAR; PG8_SCHED;
            PG8_LDB(B1, 0, 1); PG8_STAGE(PG8_SB(0, 0), b2, voffB);
            PG8_BAR; PG8_WAIT_L(0); PG8_MMA(0, 1, At, B1); PG8_BAR;
            PG8_LDA(At, 0, 1); PG8_STAGE(PG8_SA(0, 0), a2, voffA);
            PG8_BAR; PG8_WAIT_L(0); PG8_MMA(1, 0, At, B0); PG8_BAR; PG8_SCHED;
            PG8_STAGE(PG8_SB(0, 1), b2 + hstep, voffB);
            PG8_WAIT_V(6); PG8_BAR; PG8_MMA(1, 1, At, B1); PG8_BAR;
            PG8_LDB(B0, 1, 0); PG8_SCHED; PG8_LDA(At, 1, 0); PG8_STAGE(PG8_SA(0, 1), a2 + hstep, voffA);
            PG8_WAIT_L(8); PG8_BAR; PG8_WAIT_L(0); PG8_MMA(0, 0, At, B0); PG8_BAR; PG8_SCHED;
            PG8_LDB(B1, 1, 1); PG8_STAGE(PG8_SB(1, 0), b3, voffB);
            PG8_BAR; PG8_WAIT_L(0); PG8_MMA(0, 1, At, B1); PG8_BAR;
            PG8_LDA(At, 1, 1); PG8_STAGE(PG8_SA(1, 0), a3, voffA);
            PG8_BAR; PG8_WAIT_L(0); PG8_MMA(1, 0, At, B0); PG8_BAR; PG8_SCHED;
            PG8_STAGE(PG8_SB(1, 1), b3 + hstep, voffB);
            PG8_WAIT_V(6); PG8_BAR; PG8_MMA(1, 1, At, B1); PG8_BAR;
            }
        }
        if constexpr (ALIGN_EPI) { if (wr == 0) PG8_BAR; }
        if constexpr (!Epi::AFTER_DRAIN) { E(acc, cur, wr, wc, fr, fq); S.done(cur); }
        if (!has_next) break;
#pragma unroll
        for (int a = 0; a < 2; ++a)
#pragma unroll
            for (int b = 0; b < 2; ++b)
#pragma unroll
                for (int m = 0; m < 4; ++m)
#pragma unroll
                    for (int n = 0; n < 2; ++n) acc[a][b][m][n] = (f32x4){0.f, 0.f, 0.f, 0.f};
        cur = nxt; cA = nA; cB = nB; ++ui;
        if constexpr (ALIGN_EPI) { if (wr == 1) PG8_BAR; }
    }
    PG8_WAIT_V(0);
    if constexpr (!ALIGN_EPI) { if (wr == 0) PG8_BAR; }
    PG8_BAR;
    if constexpr (Epi::AFTER_DRAIN) { E.fused(acc, cur, wr, wc, fr, fq, lds, wid, lane); S.done(cur); }
#undef PG8_SA
#undef PG8_SB
#undef PG8_STAGE
#undef PG8_LDA
#undef PG8_LDB
#undef PG8_MMA
#undef PG8_WAIT_V
#undef PG8_WAIT_L
#undef PG8_BAR
#undef PG8_SCHED
}
}

#define LAS __attribute__((address_space(3)))
typedef unsigned short bf16_t;
typedef short bf16x8 __attribute__((ext_vector_type(8)));
typedef short s16x4 __attribute__((ext_vector_type(4)));
typedef float f32x4 __attribute__((ext_vector_type(4)));
typedef float f32x16 __attribute__((ext_vector_type(16)));
typedef unsigned u32x4 __attribute__((ext_vector_type(4)));
typedef unsigned u32x2 __attribute__((ext_vector_type(2)));
typedef float f32x2_t __attribute__((ext_vector_type(2)));
typedef __bf16 bf16x2_t __attribute__((ext_vector_type(2)));
#define DI __device__ __forceinline__
DI unsigned cvtpk(float lo, float hi) { f32x2_t v = {lo, hi}; bf16x2_t b = __builtin_convertvector(v, bf16x2_t); return __builtin_bit_cast(unsigned, b); }
DI float bf_lo(unsigned w) { return __uint_as_float(w << 16); }
DI float bf_hi(unsigned w) { return __uint_as_float(w & 0xffff0000u); }
DI float ex2(float x) { return __builtin_amdgcn_exp2f(x); }
DI f32x4 mfma16(bf16x8 a, bf16x8 b, f32x4 c) { return __builtin_amdgcn_mfma_f32_16x16x32_bf16(a, b, c, 0, 0, 0); }
DI f32x16 mfma32(bf16x8 a, bf16x8 b, f32x16 c) { return __builtin_amdgcn_mfma_f32_32x32x16_bf16(a, b, c, 0, 0, 0); }
DI s16x4 vtr(LAS const unsigned char* p) { typedef short v4i16_t __attribute__((ext_vector_type(4))); return __builtin_bit_cast(s16x4, __builtin_amdgcn_ds_read_tr16_b64_v4i16((LAS v4i16_t*)p)); }
DI float max3f(float a, float b, float c) { float r; asm("v_max3_f32 %0, %1, %2, %3" : "=v"(r) : "v"(a), "v"(b), "v"(c)); return r; }
DI bf16x8 cat8(s16x4 lo, s16x4 hi) { return (bf16x8){lo[0], lo[1], lo[2], lo[3], hi[0], hi[1], hi[2], hi[3]}; }

constexpr int M = 32768, MH = 16384, DM = 1024, FF = 4096;
constexpr float LN_EPS = 1e-5f, ALPHA = 1.4142135623730951f, LOG2E = 1.4426950408889634f;
constexpr float QS = 0.125f * LOG2E;
constexpr float LAM_INIT = 0.35550906759097f;
constexpr int NPHASE = 16;

constexpr size_t MiB = 1u << 20;
constexpr size_t WS_WIN0 = 0, WS_WOUT0 = 5 * MiB, WS_WFF1_0 = 7 * MiB, WS_WFF2_0 = 15 * MiB, WS_WIN1 = 23 * MiB, WS_WOUT1 = 29 * MiB, WS_WFF1_1 = 31 * MiB, WS_WFF2_1 = 39 * MiB;
constexpr size_t WS_WSP = 47 * MiB;
constexpr size_t WS_CP = 47 * MiB + 256 * 1024;
constexpr size_t WS_CF = 49 * MiB;
constexpr size_t WS_NRM = 49 * MiB + 128 * 1024;
constexpr size_t WS_CTL = 49 * MiB + 256 * 1024;
constexpr size_t WS_STA = 50 * MiB, WS_STB = 54 * MiB;
constexpr size_t WS_VST = 58 * MiB;
constexpr size_t WS_R1 = 60 * MiB;
constexpr size_t WS_R2 = 124 * MiB;
constexpr size_t WS_END = 252 * MiB;
constexpr size_t OUT_A = 0, OUT_B = 64 * MiB;
constexpr int CPS = 16 * 4096;
constexpr int LDS_BYTES = 147456;

struct Args { const float* in[28]; float* out; unsigned char* ws; int ph_lo, ph_hi; };

DI void row_stats16(const float* st, int row, int fq, float& mu, float& rstd) {
    const f32x4* p = (const f32x4*)(st + (size_t)row * 32 + fq * 8);
    const f32x4 a = p[0], b = p[1];
    float s = (a[0] + a[2]) + (b[0] + b[2]), ss = (a[1] + a[3]) + (b[1] + b[3]);
    s += __shfl_xor(s, 16); ss += __shfl_xor(ss, 16); s += __shfl_xor(s, 32); ss += __shfl_xor(ss, 32);
    mu = s * (1.f / 1024.f); const float var = fmaxf(ss * (1.f / 1024.f) - mu * mu, 0.f); rstd = rsqrtf(var + LN_EPS);
}
DI void put_stats(float* st, int row, int slot, int nslots, int fq, float s, float ss) {
    s += __shfl_xor(s, 16); ss += __shfl_xor(ss, 16); s += __shfl_xor(s, 32); ss += __shfl_xor(ss, 32);
    if (fq == 0) *(f32x2_t*)(st + ((size_t)row * nslots + slot) * 2) = (f32x2_t){s, ss};
}
DI float gelu_t(float x) {
    const float e = ex2(x * (-2.302208198f + (-0.10294324f) * x * x));
    return x * __builtin_amdgcn_rcpf(1.f + e);
}
DI u32x4 pack8(const f32x4 a, const f32x4 b) { u32x4 w; w[0] = cvtpk(a[0], a[1]); w[1] = cvtpk(a[2], a[3]); w[2] = cvtpk(b[0], b[1]); w[3] = cvtpk(b[2], b[3]); return w; }

struct EpiIn0 {
    static constexpr bool PERM = true, AFTER_DRAIN = false;
    bf16_t* UV; bf16_t* QKV; float* vst;
    DI void operator()(const f32x4 (&acc)[2][2][4][2], const pg8::Unit& u, int wr, int wc, int fr, int fq) const {
        const int colt = u.pn * 256;
        if (colt < 1024) {
            const bool isv = colt >= 512;
#pragma unroll
            for (int ai = 0; ai < 2; ++ai)
#pragma unroll
                for (int m = 0; m < 4; ++m) {
                    const int row = u.pm * 256 + ai * 128 + wr * 64 + m * 16 + fr;
                    float s = 0.f, ss = 0.f;
#pragma unroll
                    for (int bj = 0; bj < 2; ++bj) {
                        const int col = colt + bj * 128 + wc * 32 + 8 * fq;
                        f32x4 v0, v1;
#pragma unroll
                        for (int e = 0; e < 4; ++e) { v0[e] = gelu_t(acc[ai][bj][m][0][e]); v1[e] = gelu_t(acc[ai][bj][m][1][e]); }
#pragma unroll
                        for (int e = 0; e < 4; ++e) { s += v0[e] + v1[e]; ss += v0[e] * v0[e] + v1[e] * v1[e]; }
                        *(u32x4*)(UV + (size_t)row * 1024 + col) = pack8(v0, v1);
                    }
                    if (isv) put_stats(vst, row, (u.pn - 2) * 4 + wc, 8, fq, s, ss);
                }
        } else {
            const float sc = (colt < 1536) ? QS : 1.f;
#pragma unroll
            for (int ai = 0; ai < 2; ++ai)
#pragma unroll
                for (int m = 0; m < 4; ++m) {
                    const int row = u.pm * 256 + ai * 128 + wr * 64 + m * 16 + fr;
#pragma unroll
                    for (int bj = 0; bj < 2; ++bj) {
                        const int col = colt - 1024 + bj * 128 + wc * 32 + 8 * fq;
                        *(u32x4*)(QKV + (size_t)row * 1536 + col) = pack8(acc[ai][bj][m][0] * sc, acc[ai][bj][m][1] * sc);
                    }
                }
        }
    }
};

template <int SRC, bool OUTF32> struct EpiRes {
    static constexpr bool PERM = true, AFTER_DRAIN = false;
    const float* xa; const float* xb; const bf16_t* Yin; const float* stin; const float* g; const float* b;
    bf16_t* Yout; float* stout; float* Fout; int row_off;
    DI void operator()(const f32x4 (&acc)[2][2][4][2], const pg8::Unit& u, int wr, int wc, int fr, int fq) const {
        f32x4 gv[2][2], bv[2][2];
        if (SRC == 1) {
#pragma unroll
            for (int bj = 0; bj < 2; ++bj)
#pragma unroll
                for (int n = 0; n < 2; ++n) { const int col = u.pn * 256 + bj * 128 + wc * 32 + 8 * fq + 4 * n; gv[bj][n] = *(const f32x4*)(g + col) * ALPHA; bv[bj][n] = *(const f32x4*)(b + col) * ALPHA; }
        }
#pragma unroll
        for (int ai = 0; ai < 2; ++ai)
#pragma unroll
            for (int m = 0; m < 4; ++m) {
                const int row = row_off + u.pm * 256 + ai * 128 + wr * 64 + m * 16 + fr;
                float mu = 0.f, rstd = 0.f;
                if (SRC == 1) row_stats16(stin, row, fq, mu, rstd);
                float s = 0.f, ss = 0.f;
#pragma unroll
                for (int bj = 0; bj < 2; ++bj) {
                    const int col = u.pn * 256 + bj * 128 + wc * 32 + 8 * fq;
                    f32x4 r0, r1;
                    if (SRC == 0) {
                        const float* xp = (row < MH) ? xa + (size_t)row * 1024 : xb + (size_t)(row - MH) * 1024;
                        r0 = *(const f32x4*)(xp + col) * ALPHA; r1 = *(const f32x4*)(xp + col + 4) * ALPHA;
                    } else {
                        const u32x4 yw = *(const u32x4*)(Yin + (size_t)row * 1024 + col);
                        const f32x4 y0 = {bf_lo(yw[0]), bf_hi(yw[0]), bf_lo(yw[1]), bf_hi(yw[1])}, y1 = {bf_lo(yw[2]), bf_hi(yw[2]), bf_lo(yw[3]), bf_hi(yw[3])};
                        r0 = (y0 - mu) * rstd * gv[bj][0] + bv[bj][0]; r1 = (y1 - mu) * rstd * gv[bj][1] + bv[bj][1];
                    }
                    const f32x4 o0 = r0 + acc[ai][bj][m][0], o1 = r1 + acc[ai][bj][m][1];
                    if (OUTF32) { float* op = Fout + (size_t)row * 1024 + col; *(f32x4*)op = o0; *(f32x4*)(op + 4) = o1; }
                    else {
#pragma unroll
                        for (int e = 0; e < 4; ++e) { s += o0[e] + o1[e]; ss += o0[e] * o0[e] + o1[e] * o1[e]; }
                        *(u32x4*)(Yout + (size_t)row * 1024 + col) = pack8(o0, o1);
                    }
                }
                if (!OUTF32) put_stats(stout, row, u.pn * 4 + wc, 16, fq, s, ss);
            }
    }
};

template <int ACT> struct EpiFold {
    static constexpr bool PERM = true, AFTER_DRAIN = false;
    const float* stin; const float* c1; const float* c2; bf16_t* O; int ldo; int row_off; unsigned* nrm;
    DI void operator()(const f32x4 (&acc)[2][2][4][2], const pg8::Unit& u, int wr, int wc, int fr, int fq) const {
        const int colt = u.pn * 256;
        float nm[2] = {0.f, 0.f};
        f32x4 c1v[2][2], c2v[2][2];
#pragma unroll
        for (int bj = 0; bj < 2; ++bj)
#pragma unroll
            for (int n = 0; n < 2; ++n) { const int col = colt + bj * 128 + wc * 32 + 8 * fq + 4 * n; c1v[bj][n] = *(const f32x4*)(c1 + col); c2v[bj][n] = *(const f32x4*)(c2 + col); }
        const float sc = (ACT == 1 && colt < 1024) ? QS : 1.f;
#pragma unroll
        for (int ai = 0; ai < 2; ++ai)
#pragma unroll
            for (int m = 0; m < 4; ++m) {
                const int lrow = u.pm * 256 + ai * 128 + wr * 64 + m * 16 + fr;
                float mu, rstd; row_stats16(stin, row_off + lrow, fq, mu, rstd);
#pragma unroll
                for (int bj = 0; bj < 2; ++bj) {
                    const int col = colt + bj * 128 + wc * 32 + 8 * fq;
                    f32x4 t0 = (acc[ai][bj][m][0] - mu * c1v[bj][0]) * rstd + c2v[bj][0], t1 = (acc[ai][bj][m][1] - mu * c1v[bj][1]) * rstd + c2v[bj][1];
                    if (ACT == 0) {
#pragma unroll
                        for (int e = 0; e < 4; ++e) { const float a0 = fmaxf(t0[e], 0.f), a1 = fmaxf(t1[e], 0.f); t0[e] = a0 * a0; t1[e] = a1 * a1; }
                    } else {
                        t0 = t0 * sc; t1 = t1 * sc;
                        float q = ((t0[0] * t0[0] + t0[1] * t0[1]) + (t0[2] * t0[2] + t0[3] * t0[3])) + ((t1[0] * t1[0] + t1[1] * t1[1]) + (t1[2] * t1[2] + t1[3] * t1[3]));
                        q += __shfl_xor(q, 16); q += __shfl_xor(q, 32); nm[bj] = fmaxf(nm[bj], q);
                    }
                    *(u32x4*)(O + (size_t)lrow * ldo + col) = pack8(t0, t1);
                }
            }
        if (ACT == 1 && colt < 2048) {
            const int row0 = u.pm * 256, seq = (row0 < MH) ? (row0 >> 12) : 4 + ((row0 - MH) >> 11);
#pragma unroll
            for (int bj = 0; bj < 2; ++bj) {
                float v = nm[bj];
                v = fmaxf(v, __shfl_xor(v, 1)); v = fmaxf(v, __shfl_xor(v, 2)); v = fmaxf(v, __shfl_xor(v, 4)); v = fmaxf(v, __shfl_xor(v, 8));
                if (fr == 0 && fq == 0) atomicMax(nrm + seq * 64 + ((colt + bj * 128 + wc * 32) >> 5), __float_as_uint(v));
            }
        }
    }
};

DI void p0_item(const float* W, int K, int N, bf16_t* WT, LAS float* scr, int item, int lane, const float* g, const float* b, float* c1p, float* c2p) {
    const int nblk = N / 32, kb = item / nblk, nb = item % nblk, k0 = 64 * kb, n0 = 32 * nb;
    float a1 = 0.f, a2 = 0.f;
    float wv[32];
#pragma unroll
    for (int i = 0; i < 32; ++i) wv[i] = W[(size_t)(k0 + 2 * i + (lane >> 5)) * N + n0 + (lane & 31)];
#pragma unroll
    for (int i = 0; i < 32; ++i) {
        const int kk = 2 * i + (lane >> 5);
        float w = wv[i];
        if (g) { const float gw = w * g[k0 + kk]; a1 += bf_lo(cvtpk(gw, 0.f)); a2 += b[k0 + kk] * w; w = gw; }
        scr[kk * 33 + (lane & 31)] = w;
    }
    if (g) {
        a1 += __shfl_xor(a1, 32); a2 += __shfl_xor(a2, 32);
        if (lane < 32) { c1p[kb * 4096 + n0 + lane] = a1; c2p[kb * 4096 + n0 + lane] = a2; }
    }
    asm volatile("s_waitcnt lgkmcnt(0)" ::: "memory");
    const int c = lane & 7;
#pragma unroll
    for (int j = 0; j < 4; ++j) {
        const int n = (lane >> 3) + 8 * j; const LAS float* s = scr + (8 * c) * 33 + n;
        u32x4 o; o[0] = cvtpk(s[0 * 33], s[1 * 33]); o[1] = cvtpk(s[2 * 33], s[3 * 33]); o[2] = cvtpk(s[4 * 33], s[5 * 33]); o[3] = cvtpk(s[6 * 33], s[7 * 33]);
        *(u32x4*)(WT + (size_t)(n0 + n) * K + k0 + 8 * c) = o;
    }
    asm volatile("s_waitcnt lgkmcnt(0)" ::: "memory");
}

DI void phase_prologue(const Args& a, LAS unsigned char* lds, int bx, int G) {
    const int tid = threadIdx.x, lane = tid & 63, wave = tid >> 6;
    LAS float* scr = (LAS float*)(lds + wave * 16384);
    const int gw = bx * 8 + wave, NGW = G * 8;
    unsigned char* ws = a.ws;
    constexpr int I_IN0 = 16 * 80, I_OUT = 16 * 32, I_FF1 = 16 * 128, I_FF2 = 64 * 32, I_IN1 = 16 * 96;
    constexpr int NIT = I_IN0 + I_OUT + I_FF1 + I_FF2 + I_IN1 + I_OUT + I_FF1 + I_FF2;
    float* cp = (float*)(ws + WS_CP);
    for (int it = gw; it < NIT; it += NGW) {
        int r = it;
        if (r < I_IN0) { p0_item(a.in[2], 1024, 2560, (bf16_t*)(ws + WS_WIN0), scr, r, lane, nullptr, nullptr, nullptr, nullptr); continue; } r -= I_IN0;
        if (r < I_OUT) { p0_item(a.in[3], 1024, 1024, (bf16_t*)(ws + WS_WOUT0), scr, r, lane, nullptr, nullptr, nullptr, nullptr); continue; } r -= I_OUT;
        if (r < I_FF1) { p0_item(a.in[11], 1024, 4096, (bf16_t*)(ws + WS_WFF1_0), scr, r, lane, a.in[9], a.in[10], cp + 0 * CPS, cp + 1 * CPS); continue; } r -= I_FF1;
        if (r < I_FF2) { p0_item(a.in[12], 4096, 1024, (bf16_t*)(ws + WS_WFF2_0), scr, r, lane, nullptr, nullptr, nullptr, nullptr); continue; } r -= I_FF2;
        if (r < I_IN1) { p0_item(a.in[15], 1024, 3072, (bf16_t*)(ws + WS_WIN1), scr, r, lane, a.in[13], a.in[14], cp + 2 * CPS, cp + 3 * CPS); continue; } r -= I_IN1;
        if (r < I_OUT) { p0_item(a.in[16], 1024, 1024, (bf16_t*)(ws + WS_WOUT1), scr, r, lane, nullptr, nullptr, nullptr, nullptr); continue; } r -= I_OUT;
        if (r < I_FF1) { p0_item(a.in[24], 1024, 4096, (bf16_t*)(ws + WS_WFF1_1), scr, r, lane, a.in[22], a.in[23], cp + 4 * CPS, cp + 5 * CPS); continue; } r -= I_FF1;
        p0_item(a.in[25], 4096, 1024, (bf16_t*)(ws + WS_WFF2_1), scr, r, lane, nullptr, nullptr, nullptr, nullptr);
    }
    bf16_t* XB = (bf16_t*)((unsigned char*)a.out + OUT_A);
    for (int m0 = gw * 4; m0 < M; m0 += NGW * 4) {
        f32x4 v[4][4];
#pragma unroll
        for (int rr = 0; rr < 4; ++rr) { const int m = m0 + rr; const float* xr = (m < MH) ? a.in[0] + (size_t)m * 1024 : a.in[1] + (size_t)(m - MH) * 1024;
#pragma unroll
            for (int j = 0; j < 4; ++j) v[rr][j] = ((const f32x4*)xr)[lane + 64 * j]; }
#pragma unroll
        for (int rr = 0; rr < 4; ++rr)
#pragma unroll
            for (int j = 0; j < 4; ++j) { u32x2 o; o[0] = cvtpk(v[rr][j][0], v[rr][j][1]); o[1] = cvtpk(v[rr][j][2], v[rr][j][3]); ((u32x2*)(XB + (size_t)(m0 + rr) * 1024))[lane + 64 * j] = o; }
    }
    if (bx == 0) { for (int i = tid; i < 768; i += 512) ((unsigned*)(ws + WS_NRM))[i] = 0u; }
    for (int i = bx * 512 + tid; i < 32768; i += G * 512) { const f32x2_t w = ((const f32x2_t*)a.in[6])[i]; ((unsigned*)(ws + WS_WSP))[i] = cvtpk(w[0], w[1]); }
}

DI void fold_finalize(const Args& a, int bx, int G) {
    const float* cp = (const float*)(a.ws + WS_CP); float* cf = (float*)(a.ws + WS_CF);
    for (int idx = bx * 512 + (int)threadIdx.x; idx < 6 * 4096; idx += G * 512) {
        const int slot = idx >> 12, n = idx & 4095; const float* p = cp + (size_t)slot * CPS + n; float s = 0.f;
#pragma unroll
        for (int kb = 0; kb < 16; ++kb) s += p[kb * 4096];
        cf[idx] = s;
    }
}

DI void gate_unit(const Args& a, LAS unsigned char* lds, int u) {
    const int tid = threadIdx.x, lane = tid & 63, w = tid >> 6, fr = lane & 15, fq = lane >> 4;
    const int n = u >> 2, g = u & 3, t0 = n * 128;
    const bf16_t* UV = (const bf16_t*)(a.ws + WS_R1);
    const float* vst = (const float*)(a.ws + WS_VST);
    const float* lng = a.in[4]; const float* lnb = a.in[5];
#pragma unroll
    for (int k = 0; k < 4; ++k) {
        const int idx = tid + 512 * k, s = idx >> 4, ch = idx & 15, tok = t0 + s;
        const u32x4 vw = *(const u32x4*)(UV + (size_t)tok * 1024 + 512 + g * 128 + ch * 8);
        const f32x4* sp = (const f32x4*)(vst + (size_t)tok * 16);
        const f32x4 p0 = sp[0], p1 = sp[1], p2 = sp[2], p3 = sp[3];
        const float sm = ((p0[0] + p0[2]) + (p1[0] + p1[2])) + ((p2[0] + p2[2]) + (p3[0] + p3[2]));
        const float sq = ((p0[1] + p0[3]) + (p1[1] + p1[3])) + ((p2[1] + p2[3]) + (p3[1] + p3[3]));
        const float mu = sm * (1.f / 512.f), rstd = rsqrtf(fmaxf(sq * (1.f / 512.f) - mu * mu, 0.f) + LN_EPS);
        const f32x4 g0 = *(const f32x4*)(lng + g * 128 + ch * 8), g1 = *(const f32x4*)(lng + g * 128 + ch * 8 + 4);
        const f32x4 b0 = *(const f32x4*)(lnb + g * 128 + ch * 8), b1 = *(const f32x4*)(lnb + g * 128 + ch * 8 + 4);
        const f32x4 v0 = {bf_lo(vw[0]), bf_hi(vw[0]), bf_lo(vw[1]), bf_hi(vw[1])}, v1 = {bf_lo(vw[2]), bf_hi(vw[2]), bf_lo(vw[3]), bf_hi(vw[3])};
        *(LAS u32x4*)(lds + s * 288 + ch * 16) = pack8((v0 - mu) * rstd * g0 + b0, (v1 - mu) * rstd * g1 + b1);
    }
    const bf16_t* Wsb = (const bf16_t*)(a.ws + WS_WSP) + (size_t)g * 16384 + (size_t)(16 * w + fr) * 128;
    bf16x8 bw[4];
#pragma unroll
    for (int ks = 0; ks < 4; ++ks) { const u32x2 lo = *(const u32x2*)(Wsb + 32 * ks + 4 * fq), hi = *(const u32x2*)(Wsb + 32 * ks + 16 + 4 * fq); u32x4 t; t[0] = lo[0]; t[1] = lo[1]; t[2] = hi[0]; t[3] = hi[1]; bw[ks] = __builtin_bit_cast(bf16x8, t); }
    const float bsv = a.in[7][g * 128 + 16 * w + fr];
    const int i16 = lane & 15, qq = i16 >> 2, p = i16 & 3;
    LAS const unsigned char* tb = lds + (4 * fq + qq) * 288 + p * 8;
    const size_t orow = (size_t)(t0 + 16 * w + fr) * 1024 + g * 128;
    bf16_t* CAT = (bf16_t*)((unsigned char*)a.out + OUT_B);
    u32x2 uwv[8];
#pragma unroll
    for (int ct = 0; ct < 8; ++ct) uwv[ct] = *(const u32x2*)(UV + orow + 16 * ct + 4 * fq);
    __syncthreads();
#pragma unroll
    for (int ct = 0; ct < 8; ++ct) {
        f32x4 acc = {0.f, 0.f, 0.f, 0.f};
#pragma unroll
        for (int ks = 0; ks < 4; ++ks) { const s16x4 lo = vtr(tb + (32 * ks) * 288 + ct * 32), hi = vtr(tb + (32 * ks + 16) * 288 + ct * 32); acc = mfma16(cat8(lo, hi), bw[ks], acc); }
        const int c = 16 * ct + 4 * fq;
        const u32x2 uw = uwv[ct];
        u32x2 o; o[0] = cvtpk(bf_lo(uw[0]) * (acc[0] + bsv), bf_hi(uw[0]) * (acc[1] + bsv)); o[1] = cvtpk(bf_lo(uw[1]) * (acc[2] + bsv), bf_hi(uw[1]) * (acc[3] + bsv));
        *(u32x2*)(CAT + orow + c) = o;
    }
    __syncthreads();
}

DI void na_unit(const Args& a, LAS unsigned char* lds, int u) {
    const int tid = threadIdx.x, lane = tid & 63, w = tid >> 6, fr = lane & 15, fq = lane >> 4;
    int h, rp, rows, tok0;
    if (u < 1024) { h = u & 7; rp = (u >> 3) & 31; rows = 64; tok0 = (u >> 8) * 4096; }
    else { const int v = u - 1024; h = v & 7; rp = (v >> 3) & 15; rows = 32; tok0 = MH + (v >> 7) * 2048; }
    const int r0 = 2 * rp;
    const int s0 = min(max(r0 - 4, 0), rows - 8), s1 = min(max(r0 - 3, 0), rows - 8);
    const int nrl = s1 + 8 - s0;
    const bf16_t* QKV = (const bf16_t*)(a.ws + WS_R2);
    LAS float* rpl = (LAS float*)(lds + 9 * 64 * 160);
    u32x4 vst_[9];
#pragma unroll
    for (int k = 0; k < 9; ++k) {
        const int idx = tid + 512 * k, key = idx >> 3, ch = idx & 7;
        if (idx < nrl * 512) vst_[k] = *(const u32x4*)(QKV + (size_t)(tok0 + s0 * 64 + key) * 1536 + 1024 + h * 64 + ch * 8);
    }
    const float rpv = (tid < 465) ? a.in[8][h * 465 + tid] * LOG2E : 0.f;
    const int qr = w >> 2, j = w & 3, r = r0 + qr, s = qr ? s1 : s0, rowoff = s - s0;
    const int wc0 = (j == 0) ? 0 : (j == 1) ? 8 : (j == 2) ? 24 : 32;
    const size_t qtok = (size_t)(tok0 + r * 64 + 16 * j + fr);
    bf16x8 qf[2];
#pragma unroll
    for (int ks = 0; ks < 2; ++ks) qf[ks] = *(const bf16x8*)(QKV + qtok * 1536 + h * 64 + 16 * fq + 8 * ks);
    bf16x8 kf[16][2];
#pragma unroll
    for (int st = 0; st < 16; ++st) {
        const int i = st >> 1, ch = st & 1;
        const bf16_t* kp = QKV + (size_t)(tok0 + (s + i) * 64 + wc0 + 16 * ch + fr) * 1536 + 512 + h * 64 + 16 * fq;
        kf[st][0] = *(const bf16x8*)kp; kf[st][1] = *(const bf16x8*)(kp + 8);
    }
    __builtin_amdgcn_sched_barrier(0);
#pragma unroll
    for (int k = 0; k < 9; ++k) {
        const int idx = tid + 512 * k, key = idx >> 3, ch = idx & 7;
        if (idx < nrl * 512) *(LAS u32x4*)(lds + key * 160 + ch * 16) = vst_[k];
    }
    if (tid < 465) rpl[tid] = rpv;
    __syncthreads();
    f32x4 S[16];
#pragma unroll
    for (int st = 0; st < 16; ++st) { f32x4 z = {0.f, 0.f, 0.f, 0.f}; z = mfma16(kf[st][0], qf[0], z); S[st] = mfma16(kf[st][1], qf[1], z); }
    const int c = 16 * j + fr, cs = min(max(c - 8, 0), 48);
    float mx = -1e30f;
#pragma unroll
    for (int st = 0; st < 16; ++st) {
        const int i = st >> 1, ch = st & 1;
#pragma unroll
        for (int rr = 0; rr < 4; ++rr) {
            const int kc = wc0 + 16 * ch + 4 * fq + rr;
            const bool valid = (kc >= cs) && (kc < cs + 16);
            const int ci = min(max(kc - c + 15, 0), 30);
            const float bias = rpl[(s + i - r + 7) * 31 + ci];
            const float v = valid ? S[st][rr] + bias : -1e30f;
            S[st][rr] = v; mx = fmaxf(mx, v);
        }
    }
    mx = fmaxf(mx, __shfl_xor(mx, 16)); mx = fmaxf(mx, __shfl_xor(mx, 32));
    float l = 0.f;
#pragma unroll
    for (int st = 0; st < 16; ++st)
#pragma unroll
        for (int rr = 0; rr < 4; ++rr) { const float pe = ex2(S[st][rr] - mx); S[st][rr] = pe; l += pe; }
    l += __shfl_xor(l, 16); l += __shfl_xor(l, 32);
    const float inv = 1.f / l;
    bf16x8 pf[8];
#pragma unroll
    for (int i = 0; i < 8; ++i) { u32x4 t; t[0] = cvtpk(S[2 * i][0], S[2 * i][1]); t[1] = cvtpk(S[2 * i][2], S[2 * i][3]); t[2] = cvtpk(S[2 * i + 1][0], S[2 * i + 1][1]); t[3] = cvtpk(S[2 * i + 1][2], S[2 * i + 1][3]); pf[i] = __builtin_bit_cast(bf16x8, t); }
    const int i16 = lane & 15, qq = i16 >> 2, p = i16 & 3;
    LAS const unsigned char* vb = lds + (rowoff * 64 + wc0 + 4 * fq + qq) * 160 + p * 8;
    bf16_t* CAT = (bf16_t*)((unsigned char*)a.out + OUT_B) + qtok * 1024 + 512 + h * 64;
#pragma unroll
    for (int dt = 0; dt < 4; ++dt) {
        f32x4 o = {0.f, 0.f, 0.f, 0.f};
#pragma unroll
        for (int i = 0; i < 8; ++i) { const s16x4 lo = vtr(vb + (i * 64) * 160 + dt * 32), hi = vtr(vb + (i * 64 + 16) * 160 + dt * 32); o = mfma16(cat8(lo, hi), pf[i], o); }
        u32x2 ov; ov[0] = cvtpk(o[0] * inv, o[1] * inv); ov[1] = cvtpk(o[2] * inv, o[3] * inv);
        *(u32x2*)(CAT + 16 * dt + 4 * fq) = ov;
    }
    __syncthreads();
}

constexpr int AT_KB = 64 * 272, AT_VB = 64 * 320, AT_BUF = AT_KB + AT_VB;
DI void attn_unit(const Args& a, LAS unsigned char* lds, int tok0, int h, int qb, float lam, int kt_lo, int kt_hi, float km0, float km1) {
    const int tid = threadIdx.x, lane = tid & 63, w = tid >> 6, r32 = lane & 31, hi = lane >> 5;
    const int map = w & 1, qs = w >> 1;
    const bf16_t* QKV = (const bf16_t*)(a.ws + WS_R1);
    const int q0 = qb * 128 + qs * 32;
    const size_t qtok = (size_t)(tok0 + q0 + r32);
    bf16x8 qf[4];
#pragma unroll
    for (int d0 = 0; d0 < 4; ++d0) qf[d0] = *(const bf16x8*)(QKV + qtok * 3072 + h * 128 + map * 64 + 16 * d0 + 8 * hi);
    float qn2 = 0.f;
#pragma unroll
    for (int d0 = 0; d0 < 4; ++d0) { const u32x4 qw = __builtin_bit_cast(u32x4, qf[d0]);
#pragma unroll
        for (int e = 0; e < 4; ++e) { const float x0 = bf_lo(qw[e]), x1 = bf_hi(qw[e]); qn2 += x0 * x0 + x1 * x1; } }
    qn2 += __shfl_xor(qn2, 32);
    const float mref = fminf(sqrtf(qn2) * (map ? km1 : km0) * 1.01f, 40.f);
    asm volatile("" : "+v"(qf[0]), "+v"(qf[1]), "+v"(qf[2]), "+v"(qf[3]));
    const float slope2 = ex2(-(float)(h + 1)) * LOG2E;
    const int lk0 = tid >> 4, lch = tid & 15;
    const bf16_t* kg = QKV + (size_t)(tok0 + kt_lo * 64 + lk0) * 3072 + 1024 + h * 128 + lch * 8;
    const bf16_t* vg = kg + 1024;
    u32x4 kr0 = *(const u32x4*)kg, kr1 = *(const u32x4*)(kg + (size_t)32 * 3072), vr0 = *(const u32x4*)vg, vr1 = *(const u32x4*)(vg + (size_t)32 * 3072);
    LAS unsigned char* stK = lds + lk0 * 272 + lch * 16;
    LAS unsigned char* stV = lds + AT_KB + lk0 * 320 + lch * 16;
    *(LAS u32x4*)stK = kr0; *(LAS u32x4*)(stK + 32 * 272) = kr1; *(LAS u32x4*)stV = vr0; *(LAS u32x4*)(stV + 32 * 320) = vr1;
    __syncthreads();
    f32x16 o[4];
#pragma unroll
    for (int dt = 0; dt < 4; ++dt)
#pragma unroll
        for (int r = 0; r < 16; ++r) o[dt][r] = 0.f;
    float l = 0.f;
    const int i16 = lane & 15, qq = i16 >> 2, p = i16 & 3, g2 = (lane >> 4) & 1;
    for (int kt = kt_lo; kt <= kt_hi; ++kt) {
        const int buf = (kt - kt_lo) & 1;
        if (kt < kt_hi) {
            const size_t off = (size_t)(kt + 1 - kt_lo) * 64 * 3072;
            kr0 = *(const u32x4*)(kg + off); kr1 = *(const u32x4*)(kg + off + (size_t)32 * 3072); vr0 = *(const u32x4*)(vg + off); vr1 = *(const u32x4*)(vg + off + (size_t)32 * 3072);
        }
        LAS const unsigned char* kb = lds + buf * AT_BUF + r32 * 272 + (map * 64 + 8 * hi) * 2;
        f32x16 p0, p1;
        const int kbase = kt * 64;
        const float dbase = (float)(q0 + r32 - kbase - 4 * hi);
        if (kbase > q0 + 31 || kbase + 63 < q0) {
            const float cf_ = (kbase > q0 + 31) ? -slope2 : slope2;
            const float lt = -cf_ * dbase - mref;
#pragma unroll
            for (int r = 0; r < 16; ++r) { const float cc = (float)((r & 3) + 8 * (r >> 2)); p0[r] = cf_ * cc + lt; p1[r] = cf_ * (cc + 32.f) + lt; }
        } else {
#pragma unroll
            for (int r = 0; r < 16; ++r) { const float cc = (float)((r & 3) + 8 * (r >> 2)); p0[r] = -slope2 * __builtin_fabsf(dbase - cc) - mref; p1[r] = -slope2 * __builtin_fabsf(dbase - cc - 32.f) - mref; }
        }
        bf16x8 ka[4], kc[4];
#pragma unroll
        for (int d0 = 0; d0 < 4; ++d0) { ka[d0] = *(LAS const bf16x8*)(kb + d0 * 32); kc[d0] = *(LAS const bf16x8*)(kb + 32 * 272 + d0 * 32); }
        LAS const unsigned char* vbp = lds + buf * AT_BUF + AT_KB + (4 * hi + qq) * 320 + (16 * g2 + 4 * p) * 2;
        s16x4 vl0[4], vh0[4];
#pragma unroll
        for (int dt = 0; dt < 4; ++dt) { vl0[dt] = vtr(vbp + dt * 64); vh0[dt] = vtr(vbp + 8 * 320 + dt * 64); }
        __builtin_amdgcn_sched_barrier(0);
#pragma unroll
        for (int d0 = 0; d0 < 4; ++d0) p0 = mfma32(ka[d0], qf[d0], p0);
#pragma unroll
        for (int d0 = 0; d0 < 4; ++d0) p1 = mfma32(kc[d0], qf[d0], p1);
        bf16x8 pf[4];
        float ls = 0.f;
#pragma unroll
        for (int r = 0; r < 16; ++r) { p0[r] = ex2(p0[r]); ls += p0[r]; }
#pragma unroll
        for (int s = 0; s < 2; ++s) { u32x4 t0;
#pragma unroll
            for (int e = 0; e < 4; ++e) t0[e] = cvtpk(p0[8 * s + 2 * e], p0[8 * s + 2 * e + 1]);
            pf[s] = __builtin_bit_cast(bf16x8, t0); }
#pragma unroll
        for (int dt = 0; dt < 4; ++dt) o[dt] = mfma32(cat8(vl0[dt], vh0[dt]), pf[0], o[dt]);
#pragma unroll
        for (int dt = 0; dt < 4; ++dt) { const s16x4 lo = vtr(vbp + 16 * 320 + dt * 64), hh = vtr(vbp + (16 + 8) * 320 + dt * 64); o[dt] = mfma32(cat8(lo, hh), pf[1], o[dt]); }
#pragma unroll
        for (int r = 0; r < 16; ++r) { p1[r] = ex2(p1[r]); ls += p1[r]; }
#pragma unroll
        for (int s = 0; s < 2; ++s) { u32x4 t1;
#pragma unroll
            for (int e = 0; e < 4; ++e) t1[e] = cvtpk(p1[8 * s + 2 * e], p1[8 * s + 2 * e + 1]);
            pf[2 + s] = __builtin_bit_cast(bf16x8, t1); }
#pragma unroll
        for (int s = 2; s < 4; ++s)
#pragma unroll
            for (int dt = 0; dt < 4; ++dt) { const s16x4 lo = vtr(vbp + (16 * s) * 320 + dt * 64), hh = vtr(vbp + (16 * s + 8) * 320 + dt * 64); o[dt] = mfma32(cat8(lo, hh), pf[s], o[dt]); }
        l += ls;
        if (kt < kt_hi) {
            LAS unsigned char* dK = stK + (buf ^ 1) * AT_BUF; LAS unsigned char* dV = stV + (buf ^ 1) * AT_BUF;
            *(LAS u32x4*)dK = kr0; *(LAS u32x4*)(dK + 32 * 272) = kr1; *(LAS u32x4*)dV = vr0; *(LAS u32x4*)(dV + 32 * 320) = vr1;
        }
        __syncthreads();
    }
    l += __shfl_xor(l, 32);
    const float inv = 1.f / l;
    LAS float* X = (LAS float*)lds + qs * 4096;
    if (map == 1) {
        const float f = lam * inv;
#pragma unroll
        for (int dt = 0; dt < 4; ++dt)
#pragma unroll
            for (int r = 0; r < 16; ++r) X[(dt * 16 + r) * 64 + lane] = o[dt][r] * f;
    }
    __syncthreads();
    if (map == 0) {
        float ss = 0.f;
#pragma unroll
        for (int dt = 0; dt < 4; ++dt)
#pragma unroll
            for (int r = 0; r < 16; ++r) { const float v = o[dt][r] * inv - X[(dt * 16 + r) * 64 + lane]; o[dt][r] = v; ss += v * v; }
        ss += __shfl_xor(ss, 32);
        const float rs = rsqrtf(ss * (1.f / 128.f) + LN_EPS) * (1.f - LAM_INIT);
        bf16_t* O1 = (bf16_t*)((unsigned char*)a.out + OUT_B) + qtok * 1024 + h * 128;
        const float* sg = a.in[21];
#pragma unroll
        for (int dt = 0; dt < 4; ++dt)
#pragma unroll
            for (int rq = 0; rq < 4; ++rq) {
                const int dh = 32 * dt + 8 * rq + 4 * hi; const f32x4 gg = *(const f32x4*)(sg + dh);
                u32x2 wv; wv[0] = cvtpk(o[dt][4 * rq] * rs * gg[0], o[dt][4 * rq + 1] * rs * gg[1]); wv[1] = cvtpk(o[dt][4 * rq + 2] * rs * gg[2], o[dt][4 * rq + 3] * rs * gg[3]);
                *(u32x2*)(O1 + dh) = wv;
            }
    }
    __syncthreads();
}

DI float wave_sum64(float v) {
#pragma unroll
    for (int o = 1; o < 64; o <<= 1) v += __shfl_xor(v, o);
    return v;
}

#define XB_TMO      128
#define XB_XCNT(j)  (256  + 64 * (j))
#define XB_XSUB(j)  (1280 + 64 * (j))
#define XB_XGEN(j)  (2304 + 64 * (j))
#define XB_TOP      3328
#define XB_TOPGEN   3392
#define XCD_BAR_WORDS 3456
#define XB_SPIN_CAP (1u << 22)

__device__ __forceinline__ unsigned xb_ld(unsigned* p)              { return __hip_atomic_load(p, __ATOMIC_RELAXED, __HIP_MEMORY_SCOPE_AGENT); }
__device__ __forceinline__ unsigned xb_add(unsigned* p, unsigned v) { return __hip_atomic_fetch_add(p, v, __ATOMIC_RELAXED, __HIP_MEMORY_SCOPE_AGENT); }
__device__ __forceinline__ unsigned xb_xcc_id() { return (unsigned)__builtin_amdgcn_s_getreg((3 << 11) | 20) & 0xFu; }
#define XB_SPIN(cond, bar) do { unsigned _sp = 0; while (cond) { __builtin_amdgcn_s_sleep(1); \
    if ((++_sp & 255u) == 0u) { if (xb_ld(&(bar)[XB_TMO])) break; if (_sp > XB_SPIN_CAP) { atomicAdd(&(bar)[XB_TMO], 1u); break; } } } } while (0)

struct XcdBarrier {
    unsigned* bar; unsigned x;
    volatile LAS unsigned* st;
};

__device__ __forceinline__ XcdBarrier xcd_barrier_post(unsigned* bar, volatile LAS unsigned* st) {
    XcdBarrier b; b.bar = bar; b.x = xb_xcc_id(); b.st = st;
    if (threadIdx.x == 0) (void)xb_add(&bar[XB_XCNT(b.x)], 1u);
    return b;
}
__device__ __forceinline__ void xcd_barrier_complete(unsigned* bar, unsigned x, unsigned& nloc, unsigned& nx) {
    const unsigned G = gridDim.x * gridDim.y * gridDim.z;
    unsigned sum, cnt, mine, sp = 0u;
    for (;;) {
        sum = 0u; cnt = 0u; mine = 0u;
#pragma unroll
        for (unsigned j = 0; j < 16; ++j) { const unsigned c = xb_ld(&bar[XB_XCNT(j)]); sum += c; cnt += (c > 0u) ? 1u : 0u; mine = (j == x) ? c : mine; }
        if (sum == G) break;
        __builtin_amdgcn_s_sleep(1);
        if ((++sp & 255u) == 0u) { if (xb_ld(&bar[XB_TMO])) break; if (sp > XB_SPIN_CAP) { atomicAdd(&bar[XB_TMO], 1u); break; } }
    }
    nloc = mine > 0u ? mine : 1u; nx = cnt > 0u ? cnt : 1u;
}

__device__ __forceinline__ void xcd_barrier(const XcdBarrier& b) {
    asm volatile("s_waitcnt vmcnt(0)" ::: "memory");
    __syncthreads();
    if (threadIdx.x == 0) {
        unsigned* bar = b.bar;
        __builtin_amdgcn_s_waitcnt(0);
        unsigned nloc = b.st[0], nx = b.st[1];
        if (nloc == 0u) { xcd_barrier_complete(bar, b.x, nloc, nx); b.st[0] = nloc; b.st[1] = nx; }
        const unsigned old = xb_add(&bar[XB_XSUB(b.x)], 1u);
        const unsigned gen = old / nloc;
        if (old + 1u == (gen + 1u) * nloc) {
            __builtin_amdgcn_fence(__ATOMIC_RELEASE, "agent");
            asm volatile("s_waitcnt vmcnt(0)" ::: "memory");
            const unsigned og = xb_add(&bar[XB_TOP], 1u);
            const unsigned tg = og / nx;
            if (og + 1u == (tg + 1u) * nx) xb_add(&bar[XB_TOPGEN], 1u);
            else XB_SPIN(xb_ld(&bar[XB_TOPGEN]) == tg, bar);
            __builtin_amdgcn_fence(__ATOMIC_ACQUIRE, "agent");
            xb_add(&bar[XB_XGEN(b.x)], 1u);
            asm volatile("s_waitcnt vmcnt(0)" ::: "memory");
        } else {
            XB_SPIN(xb_ld(&bar[XB_XGEN(b.x)]) == gen, bar);
            __builtin_amdgcn_fence(__ATOMIC_ACQUIRE, "agent");
            asm volatile("s_waitcnt vmcnt(0)" ::: "memory");
        }
    }
    __syncthreads();
}

__global__ void __launch_bounds__(512, 2) mk_fwd(Args a) {
    extern __shared__ __attribute__((aligned(16))) unsigned char lds_raw[];
    LAS unsigned char* lds = (LAS unsigned char*)lds_raw;
    const int G = gridDim.x, bx = blockIdx.x, tid = threadIdx.x;
    unsigned char* ws = a.ws; unsigned char* ob = (unsigned char*)a.out;
#ifndef PHMASK
#define PHMASK 0xFFFF
#endif
#define IN(k) (((PHMASK >> ((k) & 15)) & 1) && a.ph_lo <= (k) && (k) < a.ph_hi)
#ifndef REPMASK
#define REPMASK 0
#endif
#define REP(k) for (int rep_ = 0; rep_ <= ((REPMASK >> ((k) & 15)) & 1); ++rep_)
#define RSYNC() do { if (rep_) xcd_barrier(bar); } while (0)
#define SEAM(k) do { if (a.ph_lo <= (k) && (k) + 1 < a.ph_hi) xcd_barrier(bar); } while (0)
    float* cf = (float*)(ws + WS_CF);
    if (tid < 16) ((LAS unsigned*)(lds + LDS_BYTES - 64))[tid] = 0u;
    __syncthreads();
    XcdBarrier bar; bar.bar = (unsigned*)(ws + WS_CTL); bar.x = 0; bar.st = (volatile LAS unsigned*)(lds + LDS_BYTES - 64);
    if (a.ph_hi - a.ph_lo > 1) bar = xcd_barrier_post((unsigned*)(ws + WS_CTL), (volatile LAS unsigned*)(lds + LDS_BYTES - 64));
    if (a.ph_hi < 0) cg::this_grid().sync();
    float* stA = (float*)(ws + WS_STA); float* stB = (float*)(ws + WS_STB);

    if (IN(0)) REP(0) { RSYNC(); phase_prologue(a, lds, bx, G); }
    SEAM(0);
    if (IN(1)) REP(1) { RSYNC();
        fold_finalize(a, bx, G);
        pg8::Gemm g{(const bf16_t*)(ob + OUT_A), (const bf16_t*)(ws + WS_WIN0), M, 2560, 1024}; pg8::StaticOrder S; S.init(M, 2560, G, bx);
        EpiIn0 E{(bf16_t*)(ws + WS_R1), (bf16_t*)(ws + WS_R2), (float*)(ws + WS_VST)};
        pg8::gemm_phase<EpiIn0, pg8::StaticOrder, true, true>(lds, g, S, E);
    }
    SEAM(1);
    if (IN(2)) REP(2) { RSYNC();
#ifdef NA_REP
        for (int rr_ = 0; rr_ < NA_REP; ++rr_)
#endif
        for (int u = bx; u < 2048; u += G) na_unit(a, lds, u);
#ifdef GATE_REP
        for (int rr_ = 0; rr_ < GATE_REP; ++rr_)
#endif
        for (int u = bx; u < 1024; u += G) gate_unit(a, lds, u);
    }
    SEAM(2);
    if (IN(3)) REP(3) { RSYNC();
        pg8::Gemm g{(const bf16_t*)(ob + OUT_B), (const bf16_t*)(ws + WS_WOUT0), M, 1024, 1024}; pg8::StaticOrder S; S.init(M, 1024, G, bx);
        EpiRes<0, false> E{a.in[0], a.in[1], nullptr, nullptr, nullptr, nullptr, (bf16_t*)(ws + WS_R1), stA, nullptr, 0};
        pg8::gemm_phase<EpiRes<0, false>, pg8::StaticOrder, true, true>(lds, g, S, E);
    }
    SEAM(3);
#pragma unroll 1
    for (int half = 0; half < 2; ++half) {
        const int p1 = 4 + 2 * half, p2 = 5 + 2 * half, ro = half * MH;
        if (IN(p1)) REP(p1) { RSYNC();
            pg8::Gemm g{(const bf16_t*)(ws + WS_R1) + (size_t)ro * 1024, (const bf16_t*)(ws + WS_WFF1_0), MH, 4096, 1024}; pg8::StaticOrder S; S.init(MH, 4096, G, bx);
            EpiFold<0> E{stA, cf + 0 * 4096, cf + 1 * 4096, (bf16_t*)(ws + WS_R2), 4096, ro, nullptr};
            pg8::gemm_phase<EpiFold<0>, pg8::StaticOrder, true, true>(lds, g, S, E);
        }
        SEAM(p1);
        if (IN(p2)) REP(p2) { RSYNC();
            pg8::Gemm g{(const bf16_t*)(ws + WS_R2), (const bf16_t*)(ws + WS_WFF2_0), MH, 1024, 4096}; pg8::StaticOrder S; S.init(MH, 1024, G, bx);
            EpiRes<1, false> E{nullptr, nullptr, (const bf16_t*)(ws + WS_R1), stA, a.in[9], a.in[10], (bf16_t*)(ob + OUT_A), stB, nullptr, ro};
            pg8::gemm_phase<EpiRes<1, false>, pg8::StaticOrder, true, true>(lds, g, S, E);
        }
        SEAM(p2);
    }
    if (IN(8)) REP(8) { RSYNC();
        pg8::Gemm g{(const bf16_t*)(ob + OUT_A), (const bf16_t*)(ws + WS_WIN1), M, 3072, 1024}; pg8::StaticOrder S; S.init(M, 3072, G, bx);
        EpiFold<1> E{stB, cf + 2 * 4096, cf + 3 * 4096, (bf16_t*)(ws + WS_R1), 3072, 0, (unsigned*)(ws + WS_NRM)};
        pg8::gemm_phase<EpiFold<1>, pg8::StaticOrder, true, true>(lds, g, S, E);
    }
    SEAM(8);
    if (IN(9)) REP(9) { RSYNC();
        const int lane = tid & 63;
        const float d1 = wave_sum64(a.in[17][lane] * a.in[18][lane]), d2 = wave_sum64(a.in[19][lane] * a.in[20][lane]);
        const float lam = __expf(d1) - __expf(d2) + LAM_INIT;
        const unsigned* nrm = (const unsigned*)(ws + WS_NRM);
        unsigned* qheads = (unsigned*)(ws + WS_CTL) + 4096;
        LAS unsigned* qslot = (LAS unsigned*)(lds + LDS_BYTES - 32);
        for (int jq = 0; jq < 8; ++jq) {
          const int x = (bx + jq) & 7, pi = x & 3, b0 = 2 * (x >> 2);
          for (;;) {
            if (tid == 0) *qslot = atomicAdd(qheads + 64 * x, 1u);
            __syncthreads();
            const int idx = (int)*qslot;
            __syncthreads();
            if (idx >= 256) break;
            int tok0, T, h, qb, seq, i2, nqb;
            if (idx < 32) { seq = b0; h = 7 - pi; i2 = idx; nqb = 32; }
            else if (idx < 64) { seq = b0 + 1; h = 4 + pi; i2 = idx - 32; nqb = 32; }
            else if (idx < 128) { seq = 4 + x; h = 7 - ((idx - 64) >> 4); i2 = (idx - 64) & 15; nqb = 16; }
            else if (idx < 160) { seq = b0 + 1; h = 3 - pi; i2 = idx - 128; nqb = 32; }
            else if (idx < 192) { seq = 4 + x; h = 3 - ((idx - 160) >> 4); i2 = (idx - 160) & 15; nqb = 16; }
            else if (idx < 224) { seq = b0; h = pi; i2 = idx - 192; nqb = 32; }
            else { seq = 4 + x; h = 1 - ((idx - 224) >> 4); i2 = (idx - 224) & 15; nqb = 16; }
            qb = (i2 & 1) ? (nqb / 2 - 1 - (i2 >> 1)) : (nqb / 2 + (i2 >> 1));
            if (nqb == 32) { tok0 = seq * 4096; T = 4096; } else { tok0 = MH + (seq - 4) * 2048; T = 2048; }
            const unsigned* nr = nrm + seq * 64 + h * 4;
            float B = 0.f, km[2];
#pragma unroll
            for (int mp = 0; mp < 2; ++mp) {
                const float Q2 = __uint_as_float(nr[mp * 2]) + __uint_as_float(nr[mp * 2 + 1]), K2 = __uint_as_float(nr[32 + mp * 2]) + __uint_as_float(nr[32 + mp * 2 + 1]);
                B = fmaxf(B, 2.04f * sqrtf(Q2 * K2)); km[mp] = sqrtf(K2);
            }
            const float dskip = (64.f + B) / (ex2(-(float)(h + 1)) * LOG2E);
            const int NT = T / 64; int kt_lo = 0, kt_hi = NT - 1;
            if (dskip < 1.0e6f) {
                kt_lo = max(0, (int)floorf(((float)(qb * 128) - dskip - 63.f) * (1.f / 64.f)));
                kt_hi = min(NT - 1, (int)ceilf(((float)(qb * 128 + 127) + dskip) * (1.f / 64.f)));
            }
            attn_unit(a, lds, tok0, h, qb, lam, kt_lo, kt_hi, km[0], km[1]);
          }
        }
    }
    SEAM(9);
    if (IN(10)) REP(10) { RSYNC();
        pg8::Gemm g{(const bf16_t*)(ob + OUT_B), (const bf16_t*)(ws + WS_WOUT1), M, 1024, 1024}; pg8::StaticOrder S; S.init(M, 1024, G, bx);
        EpiRes<1, false> E{nullptr, nullptr, (const bf16_t*)(ob + OUT_A), stB, a.in[13], a.in[14], (bf16_t*)(ws + WS_R1), stA, nullptr, 0};
        pg8::gemm_phase<EpiRes<1, false>, pg8::StaticOrder, true, true>(lds, g, S, E);
    }
    SEAM(10);
#pragma unroll 1
    for (int half = 0; half < 2; ++half) {
        const int p1 = 11 + 2 * half, p2 = 12 + 2 * half, ro = half * MH;
        if (IN(p1)) REP(p1) { RSYNC();
            pg8::Gemm g{(const bf16_t*)(ws + WS_R1) + (size_t)ro * 1024, (const bf16_t*)(ws + WS_WFF1_1), MH, 4096, 1024}; pg8::StaticOrder S; S.init(MH, 4096, G, bx);
            EpiFold<0> E{stA, cf + 4 * 4096, cf + 5 * 4096, (bf16_t*)(ws + WS_R2), 4096, ro, nullptr};
            pg8::gemm_phase<EpiFold<0>, pg8::StaticOrder, true, true>(lds, g, S, E);
        }
        SEAM(p1);
        if (IN(p2)) REP(p2) { RSYNC();
            pg8::Gemm g{(const bf16_t*)(ws + WS_R2), (const bf16_t*)(ws + WS_WFF2_1), MH, 1024, 4096}; pg8::StaticOrder S; S.init(MH, 1024, G, bx);
            EpiRes<1, true> E{nullptr, nullptr, (const bf16_t*)(ws + WS_R1), stA, a.in[22], a.in[23], nullptr, nullptr, a.out, ro};
            pg8::gemm_phase<EpiRes<1, true>, pg8::StaticOrder, true, true>(lds, g, S, E);
        }
        SEAM(p2);
    }
#ifdef EXTRA_SYNCS
    for (int es_ = 0; es_ < EXTRA_SYNCS; ++es_) xcd_barrier(bar);
#endif
    if (IN(15)) {
        const int lane = tid & 63, gw = bx * 8 + (tid >> 6), NGW = G * 8;
        const f32x4* gp = (const f32x4*)a.in[26]; const f32x4* bp = (const f32x4*)a.in[27];
        for (int m = gw; m < M; m += NGW) {
            f32x4* row = (f32x4*)(a.out + (size_t)m * 1024);
            f32x4 v[4]; float s = 0.f;
#pragma unroll
            for (int j = 0; j < 4; ++j) { v[j] = row[lane + 64 * j]; s += (v[j][0] + v[j][1]) + (v[j][2] + v[j][3]); }
            const float mean = wave_sum64(s) * (1.f / 1024.f); float s2 = 0.f;
#pragma unroll
            for (int j = 0; j < 4; ++j) { v[j] = v[j] - mean; s2 += (v[j][0] * v[j][0] + v[j][1] * v[j][1]) + (v[j][2] * v[j][2] + v[j][3] * v[j][3]); }
            const float rstd = rsqrtf(wave_sum64(s2) * (1.f / 1024.f) + LN_EPS);
#pragma unroll
            for (int j = 0; j < 4; ++j) row[lane + 64 * j] = v[j] * rstd * gp[lane + 64 * j] + bp[lane + 64 * j];
        }
    }
#undef IN
#undef SEAM
}

#ifndef MK_PER_PHASE
#define MK_PER_PHASE 0
#endif
extern "C" void kernel_launch(void* const* d_in, const int* in_sizes, int n_in, void* d_out, int out_size, void* d_ws, size_t ws_size, hipStream_t stream) {
    static int grid = 0;
    if (grid == 0) {
        if (n_in != 28 || out_size != M * DM || ws_size < WS_END) { fprintf(stderr, "kernel_launch: unexpected shapes (n_in %d out %d ws %zu)\n", n_in, out_size, ws_size); grid = -1; return; }
        int dev = 0, cus = 0, per_cu = 0;
        (void)hipGetDevice(&dev);
        (void)hipDeviceGetAttribute(&cus, hipDeviceAttributeMultiprocessorCount, dev);
        if (hipFuncSetAttribute((const void*)mk_fwd, hipFuncAttributeMaxDynamicSharedMemorySize, LDS_BYTES) != hipSuccess) { fprintf(stderr, "kernel_launch: hipFuncSetAttribute failed\n"); }
        if (hipOccupancyMaxActiveBlocksPerMultiprocessor(&per_cu, (const void*)mk_fwd, 512, LDS_BYTES) != hipSuccess || per_cu < 1) per_cu = 1;
        (void)hipGetLastError();
        if (cus <= 0) cus = 256;
        grid = cus * per_cu;
    }
    if (grid < 0) return;
    Args a{};
    for (int i = 0; i < 28; ++i) a.in[i] = (const float*)d_in[i];
    a.out = (float*)d_out; a.ws = (unsigned char*)d_ws;
#if MK_PER_PHASE
    for (int p = 0; p < NPHASE; ++p) { a.ph_lo = p; a.ph_hi = p + 1; hipLaunchKernelGGL(mk_fwd, dim3(grid), dim3(512), LDS_BYTES, stream, a); }
#else
    a.ph_lo = 0; a.ph_hi = NPHASE;
    (void)hipMemsetAsync((unsigned char*)d_ws + WS_CTL, 0, 32768, stream);
    void* args[] = {&a};
    hipError_t e = hipLaunchCooperativeKernel((const void*)mk_fwd, dim3(grid), dim3(512), args, LDS_BYTES, stream);
    if (e != hipSuccess) fprintf(stderr, "cooperative launch failed: %s (grid %d)\n", hipGetErrorString(e), grid);
#endif
}
```

```cpp
#include <hip/hip_runtime.h>
#include <hip/hip_cooperative_groups.h>
#include <cstdio>
#include <cstdint>
namespace cg = cooperative_groups;
namespace pg8 {
#define PG8_LAS __attribute__((address_space(3)))
typedef unsigned short bf16_t;
typedef short bf16x8 __attribute__((ext_vector_type(8)));
typedef float f32x4 __attribute__((ext_vector_type(4)));
typedef unsigned u32x4 __attribute__((ext_vector_type(4)));
constexpr int BM = 256, BK = 64, HALF = 128, HTB = HALF * BK * 2  , STAGE_BYTES = 8 * HTB, NXCD = 8, WGM = 8;

__host__ __device__ __forceinline__ int lds_byte(int r, int c) { const int st = (r >> 4) * 2 + (c >> 5), rr = r & 15, cc = c & 31, ob = rr * 64 + cc * 2; return st * 1024 + (ob ^ (((ob >> 9) & 1) << 5)); }
__host__ __device__ __forceinline__ void stage_rc(int b, int& R, int& C) { const int st = b / 1024, sb = b % 1024, swz = sb ^ (((sb >> 9) & 1) << 5); R = (st >> 1) * 16 + swz / 64; C = (st & 1) * 32 + (swz % 64) / 2; }
__host__ __device__ __forceinline__ int perm32(int rho) { const int n = rho >> 4, i = rho & 15; return 8 * (i >> 2) + 4 * n + (i & 3); }

struct Unit { int pm, pn; };
struct Gemm { const bf16_t* A; const bf16_t* Bt; int M, N, K; };

struct StaticOrder {
    int nM, nN, nwg, G, c;
    __host__ __device__ void init(int M, int N, int G_, int c_) { nM = M / BM; nN = N / BM; nwg = nM * nN; G = G_; c = c_; }
    __host__ __device__ bool next(int i, Unit& u) const {
        const long L = (long)i * G + c; if (L >= nwg) return false;
        int wgid = (int)L; { const int q = nwg / NXCD, r = nwg % NXCD, xcd = wgid % NXCD, off = wgid / NXCD; wgid = (xcd < r ? xcd * (q + 1) : r * (q + 1) + (xcd - r) * q) + off; }
        const int nig = WGM * nN, gid = wgid / nig, fm = gid * WGM, gsz = (nM - fm) < WGM ? (nM - fm) : WGM;
        u.pm = fm + ((wgid % nig) % gsz); u.pn = (wgid % nig) / gsz; return true;
    }
    __device__ __forceinline__ void a_ready(const Unit&) const {}
    __device__ __forceinline__ void done(const Unit&) const {}
};

template <class Epi, class Sched, bool ALIGN_EPI = false, bool SP2 = false>
__device__ __forceinline__ void gemm_phase(PG8_LAS unsigned char* lds, const Gemm g, const Sched& S, const Epi& E) {
    int tid_o = threadIdx.x; asm volatile("" : "+v"(tid_o)); const int tid = tid_o, wid = __builtin_amdgcn_readfirstlane(tid >> 6), lane = tid & 63, wr = wid >> 2, wc = wid & 3, fr = lane & 15, fq = lane >> 4;
    const int K = g.K, nt = K / BK;
    unsigned voffA[2], voffB[2];
#pragma unroll
    for (int i = 0; i < 2; ++i) { int R, C; stage_rc(tid * 16 + i * 8192, R, C); const int Rb = Epi::PERM ? ((R & ~31) + perm32(R & 31)) : R;
        voffA[i] = (unsigned)(R * K + C) * 2u; voffB[i] = (unsigned)(Rb * K + C) * 2u; }
    const size_t kstep = (size_t)(BK * 2);
    const size_t hstep = (size_t)HALF * K * 2;
    const size_t tstep = 2 * hstep;
    const unsigned ldsw = (unsigned)wid * 1024u;
    const int aoff = lds_byte(wr * 64 + fr, fq * 8), boff = lds_byte(wc * 32 + fr, fq * 8);
#define PG8_SA(b, h) (((b) * 2 + (h)) * HTB)
#define PG8_SB(b, h) ((4 + (b) * 2 + (h)) * HTB)
#define PG8_STAGE(bufoff, gbase, voff) do { _Pragma("unroll") for (int _i = 0; _i < 2; ++_i) \
        __builtin_amdgcn_global_load_lds((const unsigned*)((const char*)(gbase) + (voff)[_i]), (PG8_LAS unsigned*)(lds + (bufoff) + ldsw + _i * 8192), 16, 0, 0); } while (0)
#define PG8_LDA(dst, b, h) do { _Pragma("unroll") for (int m = 0; m < 4; ++m) _Pragma("unroll") for (int k = 0; k < 2; ++k) dst[m][k] = *(const PG8_LAS bf16x8*)(lds + PG8_SA(b, h) + aoff + m * 2048 + k * 1024); } while (0)
#define PG8_LDB(dst, b, h) do { _Pragma("unroll") for (int n = 0; n < 2; ++n) _Pragma("unroll") for (int k = 0; k < 2; ++k) dst[n][k] = *(const PG8_LAS bf16x8*)(lds + PG8_SB(b, h) + boff + n * 2048 + k * 1024); } while (0)
#define PG8_MMA(ai, bj, At, Bt) do { __builtin_amdgcn_s_setprio(1); _Pragma("unroll") for (int m = 0; m < 4; ++m) _Pragma("unroll") for (int n = 0; n < 2; ++n) _Pragma("unroll") for (int k = 0; k < 2; ++k) \
        acc[ai][bj][m][n] = __builtin_amdgcn_mfma_f32_16x16x32_bf16(Bt[n][k], At[m][k], acc[ai][bj][m][n], 0, 0, 0); __builtin_amdgcn_s_setprio(0); } while (0)
#define PG8_WAIT_V(n) asm volatile("s_waitcnt vmcnt(" #n ")" ::: "memory")
#define PG8_WAIT_L(n) asm volatile("s_waitcnt lgkmcnt(" #n ")" ::: "memory")
#define PG8_BAR __builtin_amdgcn_s_barrier()
#define PG8_SCHED __builtin_amdgcn_sched_barrier(0)
    Unit cur, nxt; int ui = 0;
    if (!S.next(0, cur)) return;
    f32x4 acc[2][2][4][2];
#pragma unroll
    for (int a = 0; a < 2; ++a)
#pragma unroll
        for (int b = 0; b < 2; ++b)
#pragma unroll
            for (int m = 0; m < 4; ++m)
#pragma unroll
                for (int n = 0; n < 2; ++n) acc[a][b][m][n] = (f32x4){0.f, 0.f, 0.f, 0.f};
    bf16x8 At[4][2], B0[2][2], B1[2][2];
    const char* cA = (const char*)g.A + (size_t)cur.pm * tstep; const char* cB = (const char*)g.Bt + (size_t)cur.pn * tstep;
    S.a_ready(cur);
    if constexpr (SP2) {
        PG8_STAGE(PG8_SB(0, 0), cB, voffB); PG8_STAGE(PG8_SB(0, 1), cB + hstep, voffB); PG8_STAGE(PG8_SA(0, 0), cA, voffA); PG8_STAGE(PG8_SA(0, 1), cA + hstep, voffA);
        if (wr == 1) PG8_BAR;
        PG8_WAIT_V(2); PG8_BAR;
        PG8_STAGE(PG8_SB(1, 0), cB + kstep, voffB); PG8_STAGE(PG8_SA(1, 0), cA + kstep, voffA); PG8_STAGE(PG8_SB(1, 1), cB + hstep + kstep, voffB);
        PG8_WAIT_V(6); PG8_BAR;
    } else {
        PG8_STAGE(PG8_SB(0, 0), cB, voffB); PG8_STAGE(PG8_SA(0, 0), cA, voffA); PG8_STAGE(PG8_SB(0, 1), cB + hstep, voffB); PG8_STAGE(PG8_SA(0, 1), cA + hstep, voffA);
        if (wr == 1) PG8_BAR;
        PG8_WAIT_V(4); PG8_BAR;
        PG8_STAGE(PG8_SB(1, 0), cB + kstep, voffB); PG8_STAGE(PG8_SA(1, 0), cA + kstep, voffA); PG8_STAGE(PG8_SB(1, 1), cB + hstep + kstep, voffB);
        PG8_WAIT_V(6); PG8_BAR;
    }
    for (;;) {
        const bool has_next = S.next(ui + 1, nxt);
        const char* nA = has_next ? (const char*)g.A + (size_t)nxt.pm * tstep : cA; const char* nB = has_next ? (const char*)g.Bt + (size_t)nxt.pn * tstep : cB;
        for (int t = 0; t < nt; t += 2) {
            const bool last = (t == nt - 2);
            const char* a1 = cA + (size_t)(t + 1) * kstep;
            const char* a2 = last ? nA : cA + (size_t)(t + 2) * kstep; const char* b2 = last ? nB : cB + (size_t)(t + 2) * kstep;
            const char* a3 = a2 + kstep; const char* b3 = b2 + kstep;
            if (last && has_next) S.a_ready(nxt);
            if constexpr (SP2) {
            PG8_LDB(B0, 0, 0); PG8_LDB(B1, 0, 1); PG8_SCHED; PG8_LDA(At, 0, 0); PG8_STAGE(PG8_SA(1, 1), a1 + hstep, voffA);
            PG8_WAIT_V(8); PG8_WAIT_L(0); PG8_BAR; PG8_MMA(0, 0, At, B0); PG8_MMA(0, 1, At, B1); PG8_BAR; PG8_SCHED;
            PG8_LDA(At, 0, 1); PG8_STAGE(PG8_SB(0, 0), b2, voffB); PG8_STAGE(PG8_SB(0, 1), b2 + hstep, voffB); PG8_STAGE(PG8_SA(0, 0), a2, voffA);
            PG8_WAIT_V(8); PG8_WAIT_L(0); PG8_BAR; PG8_MMA(1, 0, At, B0); PG8_MMA(1, 1, At, B1); PG8_BAR; PG8_SCHED;
            PG8_LDB(B0, 1, 0); PG8_LDB(B1, 1, 1); PG8_SCHED; PG8_LDA(At, 1, 0); PG8_STAGE(PG8_SA(0, 1), a2 + hstep, voffA);
            PG8_WAIT_V(8); PG8_WAIT_L(0); PG8_BAR; PG8_MMA(0, 0, At, B0); PG8_MMA(0, 1, At, B1); PG8_BAR; PG8_SCHED;
            PG8_LDA(At, 1, 1); PG8_STAGE(PG8_SB(1, 0), b3, voffB); PG8_STAGE(PG8_SB(1, 1), b3 + hstep, voffB); PG8_STAGE(PG8_SA(1, 0), a3, voffA);
            PG8_WAIT_V(8); PG8_WAIT_L(0); PG8_BAR; PG8_MMA(1, 0, At, B0); PG8_MMA(1, 1, At, B1); PG8_BAR; PG8_SCHED;
            } else {
            PG8_LDB(B0, 0, 0); PG8_SCHED; PG8_LDA(At, 0, 0); PG8_STAGE(PG8_SA(1, 1), a1 + hstep, voffA);
            PG8_WAIT_L(8); PG8_BAR; PG8_WAIT_L(0); PG8_MMA(0, 0, At, B0); PG8_BAR; PG8_SCHED;
            PG8_LDB(B1, 0, 1); PG8_STAGE(PG8_SB(0, 0), b2, voffB);
            PG8_BAR; PG8_WAIT_L(0); PG8_MMA(0, 1, At, B1); PG8_BAR;
            PG8_LDA(At, 0, 1); PG8_STAGE(PG8_SA(0, 0), a2, voffA);
            PG8_BAR; PG8_WAIT_L(0); PG8_MMA(1, 0, At, B0); PG8_BAR; PG8_SCHED;
            PG8_STAGE(PG8_SB(0, 1), b2 + hstep, voffB);
            PG8_WAIT_V(6); PG8_BAR; PG8_MMA(1, 1, At, B1); PG8_BAR;
            PG8_LDB(B0, 1, 0); PG8_SCHED; PG8_LDA(At, 1, 0); PG8_STAGE(PG8_SA(0, 1), a2 + hstep, voffA);
            PG8_WAIT_L(8); PG8_BAR; PG8_WAIT_L(0); PG8_MMA(0, 0, At, B0); PG8_BAR; PG8_SCHED;
            PG8_LDB(B1, 1, 1); PG8_STAGE(PG8_SB(1, 0), b3, voffB);
            PG8_BAR; PG8_WAIT_L(0); PG8_MMA(0, 1, At, B1); PG8_BAR;
            PG8_LDA(At, 1, 1); PG8_STAGE(PG8_SA(1, 0), a3, voffA);
            PG8_BAR; PG8_WAIT_L(0); PG8_MMA(1, 0, At, B0); PG8_BAR; PG8_SCHED;
            PG8_STAGE(PG8_SB(1, 1), b3 + hstep, voffB);
            PG8_WAIT_V(6); PG8_BAR; PG8_MMA(1, 1, At, B1); PG8_BAR;
            }
        }
        if constexpr (ALIGN_EPI) { if (wr == 0) PG8_BAR; }
        if constexpr (!Epi::AFTER_DRAIN) { E(acc, cur, wr, wc, fr, fq); S.done(cur); }
        if (!has_next) break;
#pragma unroll
        for (int a = 0; a < 2; ++a)
#pragma unroll
            for (int b = 0; b < 2; ++b)
#pragma unroll
                for (int m = 0; m < 4; ++m)
#pragma unroll
                    for (int n = 0; n < 2; ++n) acc[a][b][m][n] = (f32x4){0.f, 0.f, 0.f, 0.f};
        cur = nxt; cA = nA; cB = nB; ++ui;
        if constexpr (ALIGN_EPI) { if (wr == 1) PG8_BAR; }
    }
    PG8_WAIT_V(0);
    if constexpr (!ALIGN_EPI) { if (wr == 0) PG8_BAR; }
    PG8_BAR;
    if constexpr (Epi::AFTER_DRAIN) { E.fused(acc, cur, wr, wc, fr, fq, lds, wid, lane); S.done(cur); }
#undef PG8_SA
#undef PG8_SB
#undef PG8_STAGE
#undef PG8_LDA
#undef PG8_LDB
#undef PG8_MMA
#undef PG8_WAIT_V
#undef PG8_WAIT_L
#undef PG8_BAR
#undef PG8_SCHED
}
}

#define LAS __attribute__((address_space(3)))
typedef unsigned short bf16_t;
typedef short bf16x8 __attribute__((ext_vector_type(8)));
typedef short s16x4 __attribute__((ext_vector_type(4)));
typedef float f32x4 __attribute__((ext_vector_type(4)));
typedef float f32x16 __attribute__((ext_vector_type(16)));
typedef unsigned u32x4 __attribute__((ext_vector_type(4)));
typedef unsigned u32x2 __attribute__((ext_vector_type(2)));
typedef float f32x2_t __attribute__((ext_vector_type(2)));
typedef __bf16 bf16x2_t __attribute__((ext_vector_type(2)));
#define DI __device__ __forceinline__
DI unsigned cvtpk(float lo, float hi) { f32x2_t v = {lo, hi}; bf16x2_t b = __builtin_convertvector(v, bf16x2_t); return __builtin_bit_cast(unsigned, b); }
DI float bf_lo(unsigned w) { return __uint_as_float(w << 16); }
DI float bf_hi(unsigned w) { return __uint_as_float(w & 0xffff0000u); }
DI float ex2(float x) { return __builtin_amdgcn_exp2f(x); }
DI f32x4 mfma16(bf16x8 a, bf16x8 b, f32x4 c) { return __builtin_amdgcn_mfma_f32_16x16x32_bf16(a, b, c, 0, 0, 0); }
DI f32x16 mfma32(bf16x8 a, bf16x8 b, f32x16 c) { return __builtin_amdgcn_mfma_f32_32x32x16_bf16(a, b, c, 0, 0, 0); }
DI s16x4 vtr(LAS const unsigned char* p) { typedef short v4i16_t __attribute__((ext_vector_type(4))); return __builtin_bit_cast(s16x4, __builtin_amdgcn_ds_read_tr16_b64_v4i16((LAS v4i16_t*)p)); }
DI float max3f(float a, float b, float c) { float r; asm("v_max3_f32 %0, %1, %2, %3" : "=v"(r) : "v"(a), "v"(b), "v"(c)); return r; }
DI bf16x8 cat8(s16x4 lo, s16x4 hi) { return (bf16x8){lo[0], lo[1], lo[2], lo[3], hi[0], hi[1], hi[2], hi[3]}; }

constexpr int M = 32768, MH = 16384, DM = 1024, FF = 4096;
constexpr float LN_EPS = 1e-5f, ALPHA = 1.4142135623730951f, LOG2E = 1.4426950408889634f;
constexpr float QS = 0.125f * LOG2E;
constexpr float LAM_INIT = 0.35550906759097f;
constexpr int NPHASE = 16;

constexpr size_t MiB = 1u << 20;
constexpr size_t WS_WIN0 = 0, WS_WOUT0 = 5 * MiB, WS_WFF1_0 = 7 * MiB, WS_WFF2_0 = 15 * MiB, WS_WIN1 = 23 * MiB, WS_WOUT1 = 29 * MiB, WS_WFF1_1 = 31 * MiB, WS_WFF2_1 = 39 * MiB;
constexpr size_t WS_WSP = 47 * MiB;
constexpr size_t WS_CP = 47 * MiB + 256 * 1024;
constexpr size_t WS_CF = 49 * MiB;
constexpr size_t WS_NRM = 49 * MiB + 128 * 1024;
constexpr size_t WS_CTL = 49 * MiB + 256 * 1024;
constexpr size_t WS_STA = 50 * MiB, WS_STB = 54 * MiB;
constexpr size_t WS_VST = 58 * MiB;
constexpr size_t WS_R1 = 60 * MiB;
constexpr size_t WS_R2 = 124 * MiB;
constexpr size_t WS_END = 252 * MiB;
constexpr size_t OUT_A = 0, OUT_B = 64 * MiB;
constexpr int CPS = 16 * 4096;
constexpr int LDS_BYTES = 147456;

struct Args { const float* in[28]; float* out; unsigned char* ws; int ph_lo, ph_hi; };

DI void row_stats16(const float* st, int row, int fq, float& mu, float& rstd) {
    const f32x4* p = (const f32x4*)(st + (size_t)row * 32 + fq * 8);
    const f32x4 a = p[0], b = p[1];
    float s = (a[0] + a[2]) + (b[0] + b[2]), ss = (a[1] + a[3]) + (b[1] + b[3]);
    s += __shfl_xor(s, 16); ss += __shfl_xor(ss, 16); s += __shfl_xor(s, 32); ss += __shfl_xor(ss, 32);
    mu = s * (1.f / 1024.f); const float var = fmaxf(ss * (1.f / 1024.f) - mu * mu, 0.f); rstd = rsqrtf(var + LN_EPS);
}
DI void put_stats(float* st, int row, int slot, int nslots, int fq, float s, float ss) {
    s += __shfl_xor(s, 16); ss += __shfl_xor(ss, 16); s += __shfl_xor(s, 32); ss += __shfl_xor(ss, 32);
    if (fq == 0) *(f32x2_t*)(st + ((size_t)row * nslots + slot) * 2) = (f32x2_t){s, ss};
}
DI float gelu_t(float x) {
    const float e = ex2(x * (-2.302208198f + (-0.10294324f) * x * x));
    return x * __builtin_amdgcn_rcpf(1.f + e);
}
DI u32x4 pack8(const f32x4 a, const f32x4 b) { u32x4 w; w[0] = cvtpk(a[0], a[1]); w[1] = cvtpk(a[2], a[3]); w[2] = cvtpk(b[0], b[1]); w[3] = cvtpk(b[2], b[3]); return w; }

struct EpiIn0 {
    static constexpr bool PERM = true, AFTER_DRAIN = false;
    bf16_t* UV; bf16_t* QKV; float* vst;
    DI void operator()(const f32x4 (&acc)[2][2][4][2], const pg8::Unit& u, int wr, int wc, int fr, int fq) const {
        const int colt = u.pn * 256;
        if (colt < 1024) {
            const bool isv = colt >= 512;
#pragma unroll
            for (int ai = 0; ai < 2; ++ai)
#pragma unroll
                for (int m = 0; m < 4; ++m) {
                    const int row = u.pm * 256 + ai * 128 + wr * 64 + m * 16 + fr;
                    float s = 0.f, ss = 0.f;
#pragma unroll
                    for (int bj = 0; bj < 2; ++bj) {
                        const int col = colt + bj * 128 + wc * 32 + 8 * fq;
                        f32x4 v0, v1;
#pragma unroll
                        for (int e = 0; e < 4; ++e) { v0[e] = gelu_t(acc[ai][bj][m][0][e]); v1[e] = gelu_t(acc[ai][bj][m][1][e]); }
#pragma unroll
                        for (int e = 0; e < 4; ++e) { s += v0[e] + v1[e]; ss += v0[e] * v0[e] + v1[e] * v1[e]; }
                        *(u32x4*)(UV + (size_t)row * 1024 + col) = pack8(v0, v1);
                    }
                    if (isv) put_stats(vst, row, (u.pn - 2) * 4 + wc, 8, fq, s, ss);
                }
        } else {
            const float sc = (colt < 1536) ? QS : 1.f;
#pragma unroll
            for (int ai = 0; ai < 2; ++ai)
#pragma unroll
                for (int m = 0; m < 4; ++m) {
                    const int row = u.pm * 256 + ai * 128 + wr * 64 + m * 16 + fr;
#pragma unroll
                    for (int bj = 0; bj < 2; ++bj) {
                        const int col = colt - 1024 + bj * 128 + wc * 32 + 8 * fq;
                        *(u32x4*)(QKV + (size_t)row * 1536 + col) = pack8(acc[ai][bj][m][0] * sc, acc[ai][bj][m][1] * sc);
                    }
                }
        }
    }
};

template <int SRC, bool OUTF32> struct EpiRes {
    static constexpr bool PERM = true, AFTER_DRAIN = false;
    const float* xa; const float* xb; const bf16_t* Yin; const float* stin; const float* g; const float* b;
    bf16_t* Yout; float* stout; float* Fout; int row_off;
    DI void operator()(const f32x4 (&acc)[2][2][4][2], const pg8::Unit& u, int wr, int wc, int fr, int fq) const {
        f32x4 gv[2][2], bv[2][2];
        if (SRC == 1) {
#pragma unroll
            for (int bj = 0; bj < 2; ++bj)
#pragma unroll
                for (int n = 0; n < 2; ++n) { const int col = u.pn * 256 + bj * 128 + wc * 32 + 8 * fq + 4 * n; gv[bj][n] = *(const f32x4*)(g + col) * ALPHA; bv[bj][n] = *(const f32x4*)(b + col) * ALPHA; }
        }
#pragma unroll
        for (int ai = 0; ai < 2; ++ai)
#pragma unroll
            for (int m = 0; m < 4; ++m) {
                const int row = row_off + u.pm * 256 + ai * 128 + wr * 64 + m * 16 + fr;
                float mu = 0.f, rstd = 0.f;
                if (SRC == 1) row_stats16(stin, row, fq, mu, rstd);
                float s = 0.f, ss = 0.f;
#pragma unroll
                for (int bj = 0; bj < 2; ++bj) {
                    const int col = u.pn * 256 + bj * 128 + wc * 32 + 8 * fq;
                    f32x4 r0, r1;
                    if (SRC == 0) {
                        const float* xp = (row < MH) ? xa + (size_t)row * 1024 : xb + (size_t)(row - MH) * 1024;
                        r0 = *(const f32x4*)(xp + col) * ALPHA; r1 = *(const f32x4*)(xp + col + 4) * ALPHA;
                    } else {
                        const u32x4 yw = *(const u32x4*)(Yin + (size_t)row * 1024 + col);
                        const f32x4 y0 = {bf_lo(yw[0]), bf_hi(yw[0]), bf_lo(yw[1]), bf_hi(yw[1])}, y1 = {bf_lo(yw[2]), bf_hi(yw[2]), bf_lo(yw[3]), bf_hi(yw[3])};
                        r0 = (y0 - mu) * rstd * gv[bj][0] + bv[bj][0]; r1 = (y1 - mu) * rstd * gv[bj][1] + bv[bj][1];
                    }
                    const f32x4 o0 = r0 + acc[ai][bj][m][0], o1 = r1 + acc[ai][bj][m][1];
                    if (OUTF32) { float* op = Fout + (size_t)row * 1024 + col; *(f32x4*)op = o0; *(f32x4*)(op + 4) = o1; }
                    else {
#pragma unroll
                        for (int e = 0; e < 4; ++e) { s += o0[e] + o1[e]; ss += o0[e] * o0[e] + o1[e] * o1[e]; }
                        *(u32x4*)(Yout + (size_t)row * 1024 + col) = pack8(o0, o1);
                    }
                }
                if (!OUTF32) put_stats(stout, row, u.pn * 4 + wc, 16, fq, s, ss);
            }
    }
};

template <int ACT> struct EpiFold {
    static constexpr bool PERM = true, AFTER_DRAIN = false;
    const float* stin; const float* c1; const float* c2; bf16_t* O; int ldo; int row_off; unsigned* nrm;
    DI void operator()(const f32x4 (&acc)[2][2][4][2], const pg8::Unit& u, int wr, int wc, int fr, int fq) const {
        const int colt = u.pn * 256;
        float nm[2] = {0.f, 0.f};
        f32x4 c1v[2][2], c2v[2][2];
#pragma unroll
        for (int bj = 0; bj < 2; ++bj)
#pragma unroll
            for (int n = 0; n < 2; ++n) { const int col = colt + bj * 128 + wc * 32 + 8 * fq + 4 * n; c1v[bj][n] = *(const f32x4*)(c1 + col); c2v[bj][n] = *(const f32x4*)(c2 + col); }
        const float sc = (ACT == 1 && colt < 1024) ? QS : 1.f;
#pragma unroll
        for (int ai = 0; ai < 2; ++ai)
#pragma unroll
            for (int m = 0; m < 4; ++m) {
                const int lrow = u.pm * 256 + ai * 128 + wr * 64 + m * 16 + fr;
                float mu, rstd; row_stats16(stin, row_off + lrow, fq, mu, rstd);
#pragma unroll
                for (int bj = 0; bj < 2; ++bj) {
                    const int col = colt + bj * 128 + wc * 32 + 8 * fq;
                    f32x4 t0 = (acc[ai][bj][m][0] - mu * c1v[bj][0]) * rstd + c2v[bj][0], t1 = (acc[ai][bj][m][1] - mu * c1v[bj][1]) * rstd + c2v[bj][1];
                    if (ACT == 0) {
#pragma unroll
                        for (int e = 0; e < 4; ++e) { const float a0 = fmaxf(t0[e], 0.f), a1 = fmaxf(t1[e], 0.f); t0[e] = a0 * a0; t1[e] = a1 * a1; }
                    } else {
                        t0 = t0 * sc; t1 = t1 * sc;
                        float q = ((t0[0] * t0[0] + t0[1] * t0[1]) + (t0[2] * t0[2] + t0[3] * t0[3])) + ((t1[0] * t1[0] + t1[1] * t1[1]) + (t1[2] * t1[2] + t1[3] * t1[3]));
                        q += __shfl_xor(q, 16); q += __shfl_xor(q, 32); nm[bj] = fmaxf(nm[bj], q);
                    }
                    *(u32x4*)(O + (size_t)lrow * ldo + col) = pack8(t0, t1);
                }
            }
        if (ACT == 1 && colt < 2048) {
            const int row0 = u.pm * 256, seq = (row0 < MH) ? (row0 >> 12) : 4 + ((row0 - MH) >> 11);
#pragma unroll
            for (int bj = 0; bj < 2; ++bj) {
                float v = nm[bj];
                v = fmaxf(v, __shfl_xor(v, 1)); v = fmaxf(v, __shfl_xor(v, 2)); v = fmaxf(v, __shfl_xor(v, 4)); v = fmaxf(v, __shfl_xor(v, 8));
                if (fr == 0 && fq == 0) atomicMax(nrm + seq * 64 + ((colt + bj * 128 + wc * 32) >> 5), __float_as_uint(v));
            }
        }
    }
};

DI void p0_item(const float* W, int K, int N, bf16_t* WT, LAS float* scr, int item, int lane, const float* g, const float* b, float* c1p, float* c2p) {
    const int nblk = N / 32, kb = item / nblk, nb = item % nblk, k0 = 64 * kb, n0 = 32 * nb;
    float a1 = 0.f, a2 = 0.f;
    float wv[32];
#pragma unroll
    for (int i = 0; i < 32; ++i) wv[i] = W[(size_t)(k0 + 2 * i + (lane >> 5)) * N + n0 + (lane & 31)];
#pragma unroll
    for (int i = 0; i < 32; ++i) {
        const int kk = 2 * i + (lane >> 5);
        float w = wv[i];
        if (g) { const float gw = w * g[k0 + kk]; a1 += bf_lo(cvtpk(gw, 0.f)); a2 += b[k0 + kk] * w; w = gw; }
        scr[kk * 33 + (lane & 31)] = w;
    }
    if (g) {
        a1 += __shfl_xor(a1, 32); a2 += __shfl_xor(a2, 32);
        if (lane < 32) { c1p[kb * 4096 + n0 + lane] = a1; c2p[kb * 4096 + n0 + lane] = a2; }
    }
    asm volatile("s_waitcnt lgkmcnt(0)" ::: "memory");
    const int c = lane & 7;
#pragma unroll
    for (int j = 0; j < 4; ++j) {
        const int n = (lane >> 3) + 8 * j; const LAS float* s = scr + (8 * c) * 33 + n;
        u32x4 o; o[0] = cvtpk(s[0 * 33], s[1 * 33]); o[1] = cvtpk(s[2 * 33], s[3 * 33]); o[2] = cvtpk(s[4 * 33], s[5 * 33]); o[3] = cvtpk(s[6 * 33], s[7 * 33]);
        *(u32x4*)(WT + (size_t)(n0 + n) * K + k0 + 8 * c) = o;
    }
    asm volatile("s_waitcnt lgkmcnt(0)" ::: "memory");
}

DI void phase_prologue(const Args& a, LAS unsigned char* lds, int bx, int G) {
    const int tid = threadIdx.x, lane = tid & 63, wave = tid >> 6;
    LAS float* scr = (LAS float*)(lds + wave * 16384);
    const int gw = bx * 8 + wave, NGW = G * 8;
    unsigned char* ws = a.ws;
    constexpr int I_IN0 = 16 * 80, I_OUT = 16 * 32, I_FF1 = 16 * 128, I_FF2 = 64 * 32, I_IN1 = 16 * 96;
    constexpr int NIT = I_IN0 + I_OUT + I_FF1 + I_FF2 + I_IN1 + I_OUT + I_FF1 + I_FF2;
    float* cp = (float*)(ws + WS_CP);
    for (int it = gw; it < NIT; it += NGW) {
        int r = it;
        if (r < I_IN0) { p0_item(a.in[2], 1024, 2560, (bf16_t*)(ws + WS_WIN0), scr, r, lane, nullptr, nullptr, nullptr, nullptr); continue; } r -= I_IN0;
        if (r < I_OUT) { p0_item(a.in[3], 1024, 1024, (bf16_t*)(ws + WS_WOUT0), scr, r, lane, nullptr, nullptr, nullptr, nullptr); continue; } r -= I_OUT;
        if (r < I_FF1) { p0_item(a.in[11], 1024, 4096, (bf16_t*)(ws + WS_WFF1_0), scr, r, lane, a.in[9], a.in[10], cp + 0 * CPS, cp + 1 * CPS); continue; } r -= I_FF1;
        if (r < I_FF2) { p0_item(a.in[12], 4096, 1024, (bf16_t*)(ws + WS_WFF2_0), scr, r, lane, nullptr, nullptr, nullptr, nullptr); continue; } r -= I_FF2;
        if (r < I_IN1) { p0_item(a.in[15], 1024, 3072, (bf16_t*)(ws + WS_WIN1), scr, r, lane, a.in[13], a.in[14], cp + 2 * CPS, cp + 3 * CPS); continue; } r -= I_IN1;
        if (r < I_OUT) { p0_item(a.in[16], 1024, 1024, (bf16_t*)(ws + WS_WOUT1), scr, r, lane, nullptr, nullptr, nullptr, nullptr); continue; } r -= I_OUT;
        if (r < I_FF1) { p0_item(a.in[24], 1024, 4096, (bf16_t*)(ws + WS_WFF1_1), scr, r, lane, a.in[22], a.in[23], cp + 4 * CPS, cp + 5 * CPS); continue; } r -= I_FF1;
        p0_item(a.in[25], 4096, 1024, (bf16_t*)(ws + WS_WFF2_1), scr, r, lane, nullptr, nullptr, nullptr, nullptr);
    }
    bf16_t* XB = (bf16_t*)((unsigned char*)a.out + OUT_A);
    for (int m0 = gw * 4; m0 < M; m0 += NGW * 4) {
        f32x4 v[4][4];
#pragma unroll
        for (int rr = 0; rr < 4; ++rr) { const int m = m0 + rr; const float* xr = (m < MH) ? a.in[0] + (size_t)m * 1024 : a.in[1] + (size_t)(m - MH) * 1024;
#pragma unroll
            for (int j = 0; j < 4; ++j) v[rr][j] = ((const f32x4*)xr)[lane + 64 * j]; }
#pragma unroll
        for (int rr = 0; rr < 4; ++rr)
#pragma unroll
            for (int j = 0; j < 4; ++j) { u32x2 o; o[0] = cvtpk(v[rr][j][0], v[rr][j][1]); o[1] = cvtpk(v[rr][j][2], v[rr][j][3]); ((u32x2*)(XB + (size_t)(m0 + rr) * 1024))[lane + 64 * j] = o; }
    }
    if (bx == 0) { for (int i = tid; i < 768; i += 512) ((unsigned*)(ws + WS_NRM))[i] = 0u; }
    for (int i = bx * 512 + tid; i < 32768; i += G * 512) { const f32x2_t w = ((const f32x2_t*)a.in[6])[i]; ((unsigned*)(ws + WS_WSP))[i] = cvtpk(w[0], w[1]); }
}

DI void fold_finalize(const Args& a, int bx, int G) {
    const float* cp = (const float*)(a.ws + WS_CP); float* cf = (float*)(a.ws + WS_CF);
    for (int idx = bx * 512 + (int)threadIdx.x; idx < 6 * 4096; idx += G * 512) {
        const int slot = idx >> 12, n = idx & 4095; const float* p = cp + (size_t)slot * CPS + n; float s = 0.f;
#pragma unroll
        for (int kb = 0; kb < 16; ++kb) s += p[kb * 4096];
        cf[idx] = s;
    }
}

DI void gate_unit(const Args& a, LAS unsigned char* lds, int u) {
    const int tid = threadIdx.x, lane = tid & 63, w = tid >> 6, fr = lane & 15, fq = lane >> 4;
    const int n = u >> 2, g = u & 3, t0 = n * 128;
    const bf16_t* UV = (const bf16_t*)(a.ws + WS_R1);
    const float* vst = (const float*)(a.ws + WS_VST);
    const float* lng = a.in[4]; const float* lnb = a.in[5];
#pragma unroll
    for (int k = 0; k < 4; ++k) {
        const int idx = tid + 512 * k, s = idx >> 4, ch = idx & 15, tok = t0 + s;
        const u32x4 vw = *(const u32x4*)(UV + (size_t)tok * 1024 + 512 + g * 128 + ch * 8);
        const f32x4* sp = (const f32x4*)(vst + (size_t)tok * 16);
        const f32x4 p0 = sp[0], p1 = sp[1], p2 = sp[2], p3 = sp[3];
        const float sm = ((p0[0] + p0[2]) + (p1[0] + p1[2])) + ((p2[0] + p2[2]) + (p3[0] + p3[2]));
        const float sq = ((p0[1] + p0[3]) + (p1[1] + p1[3])) + ((p2[1] + p2[3]) + (p3[1] + p3[3]));
        const float mu = sm * (1.f / 512.f), rstd = rsqrtf(fmaxf(sq * (1.f / 512.f) - mu * mu, 0.f) + LN_EPS);
        const f32x4 g0 = *(const f32x4*)(lng + g * 128 + ch * 8), g1 = *(const f32x4*)(lng + g * 128 + ch * 8 + 4);
        const f32x4 b0 = *(const f32x4*)(lnb + g * 128 + ch * 8), b1 = *(const f32x4*)(lnb + g * 128 + ch * 8 + 4);
        const f32x4 v0 = {bf_lo(vw[0]), bf_hi(vw[0]), bf_lo(vw[1]), bf_hi(vw[1])}, v1 = {bf_lo(vw[2]), bf_hi(vw[2]), bf_lo(vw[3]), bf_hi(vw[3])};
        *(LAS u32x4*)(lds + s * 288 + ch * 16) = pack8((v0 - mu) * rstd * g0 + b0, (v1 - mu) * rstd * g1 + b1);
    }
    const bf16_t* Wsb = (const bf16_t*)(a.ws + WS_WSP) + (size_t)g * 16384 + (size_t)(16 * w + fr) * 128;
    bf16x8 bw[4];
#pragma unroll
    for (int ks = 0; ks < 4; ++ks) { const u32x2 lo = *(const u32x2*)(Wsb + 32 * ks + 4 * fq), hi = *(const u32x2*)(Wsb + 32 * ks + 16 + 4 * fq); u32x4 t; t[0] = lo[0]; t[1] = lo[1]; t[2] = hi[0]; t[3] = hi[1]; bw[ks] = __builtin_bit_cast(bf16x8, t); }
    const float bsv = a.in[7][g * 128 + 16 * w + fr];
    const int i16 = lane & 15, qq = i16 >> 2, p = i16 & 3;
    LAS const unsigned char* tb = lds + (4 * fq + qq) * 288 + p * 8;
    const size_t orow = (size_t)(t0 + 16 * w + fr) * 1024 + g * 128;
    bf16_t* CAT = (bf16_t*)((unsigned char*)a.out + OUT_B);
    u32x2 uwv[8];
#pragma unroll
    for (int ct = 0; ct < 8; ++ct) uwv[ct] = *(const u32x2*)(UV + orow + 16 * ct + 4 * fq);
    __syncthreads();
#pragma unroll
    for (int ct = 0; ct < 8; ++ct) {
        f32x4 acc = {0.f, 0.f, 0.f, 0.f};
#pragma unroll
        for (int ks = 0; ks < 4; ++ks) { const s16x4 lo = vtr(tb + (32 * ks) * 288 + ct * 32), hi = vtr(tb + (32 * ks + 16) * 288 + ct * 32); acc = mfma16(cat8(lo, hi), bw[ks], acc); }
        const int c = 16 * ct + 4 * fq;
        const u32x2 uw = uwv[ct];
        u32x2 o; o[0] = cvtpk(bf_lo(uw[0]) * (acc[0] + bsv), bf_hi(uw[0]) * (acc[1] + bsv)); o[1] = cvtpk(bf_lo(uw[1]) * (acc[2] + bsv), bf_hi(uw[1]) * (acc[3] + bsv));
        *(u32x2*)(CAT + orow + c) = o;
    }
    __syncthreads();
}

DI void na_unit(const Args& a, LAS unsigned char* lds, int u) {
    const int tid = threadIdx.x, lane = tid & 63, w = tid >> 6, fr = lane & 15, fq = lane >> 4;
    int h, rp, rows, tok0;
    if (u < 1024) { h = u & 7; rp = (u >> 3) & 31; rows = 64; tok0 = (u >> 8) * 4096; }
    else { const int v = u - 1024; h = v & 7; rp = (v >> 3) & 15; rows = 32; tok0 = MH + (v >> 7) * 2048; }
    const int r0 = 2 * rp;
    const int s0 = min(max(r0 - 4, 0), rows - 8), s1 = min(max(r0 - 3, 0), rows - 8);
    const int nrl = s1 + 8 - s0;
    const bf16_t* QKV = (const bf16_t*)(a.ws + WS_R2);
    LAS float* rpl = (LAS float*)(lds + 9 * 64 * 160);
    u32x4 kst_[9], vst_[9];
#pragma unroll
    for (int k = 0; k < 9; ++k) {
        const int idx = tid + 512 * k, key = idx >> 3, ch = idx & 7;
        if (idx < nrl * 512) { const bf16_t* src = QKV + (size_t)(tok0 + s0 * 64 + key) * 1536 + 512 + h * 64 + ch * 8; kst_[k] = *(const u32x4*)src; vst_[k] = *(const u32x4*)(src + 512); }
    }
    const float rpv = (tid < 465) ? a.in[8][h * 465 + tid] * LOG2E : 0.f;
    const int qr = w >> 2, j = w & 3, r = r0 + qr, s = qr ? s1 : s0, rowoff = s - s0;
    const int wc0 = (j == 0) ? 0 : (j == 1) ? 8 : (j == 2) ? 24 : 32;
    const size_t qtok = (size_t)(tok0 + r * 64 + 16 * j + fr);
    bf16x8 qf[2];
#pragma unroll
    for (int ks = 0; ks < 2; ++ks) qf[ks] = *(const bf16x8*)(QKV + qtok * 1536 + h * 64 + 16 * fq + 8 * ks);
#pragma unroll
    for (int k = 0; k < 9; ++k) {
        const int idx = tid + 512 * k, key = idx >> 3, ch = idx & 7;
        if (idx < nrl * 512) *(LAS u32x4*)(lds + key * 144 + ch * 16) = kst_[k];
    }
    if (tid < 465) rpl[tid] = rpv;
    __syncthreads();
    f32x4 S[16];
    {
        LAS const unsigned char* kb = lds + (rowoff * 64 + wc0 + fr) * 144 + 32 * fq;
#pragma unroll
        for (int st = 0; st < 16; ++st) {
            const int i = st >> 1, ch = st & 1;
            const bf16x8 k0 = *(LAS const bf16x8*)(kb + (i * 64 + 16 * ch) * 144), k1 = *(LAS const bf16x8*)(kb + (i * 64 + 16 * ch) * 144 + 16);
            f32x4 z = {0.f, 0.f, 0.f, 0.f}; z = mfma16(k0, qf[0], z); S[st] = mfma16(k1, qf[1], z);
        }
    }
    __syncthreads();
#pragma unroll
    for (int k = 0; k < 9; ++k) {
        const int idx = tid + 512 * k, key = idx >> 3, ch = idx & 7;
        if (idx < nrl * 512) *(LAS u32x4*)(lds + key * 160 + ch * 16) = vst_[k];
    }
    const int c = 16 * j + fr, cs = min(max(c - 8, 0), 48);
    float mx = -1e30f;
#pragma unroll
    for (int st = 0; st < 16; ++st) {
        const int i = st >> 1, ch = st & 1;
#pragma unroll
        for (int rr = 0; rr < 4; ++rr) {
            const int kc = wc0 + 16 * ch + 4 * fq + rr;
            const bool valid = (kc >= cs) && (kc < cs + 16);
            const int ci = min(max(kc - c + 15, 0), 30);
            const float bias = rpl[(s + i - r + 7) * 31 + ci];
            const float v = valid ? S[st][rr] + bias : -1e30f;
            S[st][rr] = v; mx = fmaxf(mx, v);
        }
    }
    mx = fmaxf(mx, __shfl_xor(mx, 16)); mx = fmaxf(mx, __shfl_xor(mx, 32));
    float l = 0.f;
#pragma unroll
    for (int st = 0; st < 16; ++st)
#pragma unroll
        for (int rr = 0; rr < 4; ++rr) { const float pe = ex2(S[st][rr] - mx); S[st][rr] = pe; l += pe; }
    l += __shfl_xor(l, 16); l += __shfl_xor(l, 32);
    const float inv = 1.f / l;
    bf16x8 pf[8];
#pragma unroll
    for (int i = 0; i < 8; ++i) { u32x4 t; t[0] = cvtpk(S[2 * i][0], S[2 * i][1]); t[1] = cvtpk(S[2 * i][2], S[2 * i][3]); t[2] = cvtpk(S[2 * i + 1][0], S[2 * i + 1][1]); t[3] = cvtpk(S[2 * i + 1][2], S[2 * i + 1][3]); pf[i] = __builtin_bit_cast(bf16x8, t); }
    __syncthreads();
    const int i16 = lane & 15, qq = i16 >> 2, p = i16 & 3;
    LAS const unsigned char* vb = lds + (rowoff * 64 + wc0 + 4 * fq + qq) * 160 + p * 8;
    bf16_t* CAT = (bf16_t*)((unsigned char*)a.out + OUT_B) + qtok * 1024 + 512 + h * 64;
#pragma unroll
    for (int dt = 0; dt < 4; ++dt) {
        f32x4 o = {0.f, 0.f, 0.f, 0.f};
#pragma unroll
        for (int i = 0; i < 8; ++i) { const s16x4 lo = vtr(vb + (i * 64) * 160 + dt * 32), hi = vtr(vb + (i * 64 + 16) * 160 + dt * 32); o = mfma16(cat8(lo, hi), pf[i], o); }
        u32x2 ov; ov[0] = cvtpk(o[0] * inv, o[1] * inv); ov[1] = cvtpk(o[2] * inv, o[3] * inv);
        *(u32x2*)(CAT + 16 * dt + 4 * fq) = ov;
    }
    __syncthreads();
}

constexpr int AT_KB = 64 * 272, AT_VB = 64 * 320, AT_BUF = AT_KB + AT_VB;
DI void attn_unit(const Args& a, LAS unsigned char* lds, int tok0, int h, int qb, float lam, int kt_lo, int kt_hi, float km0, float km1) {
    const int tid = threadIdx.x, lane = tid & 63, w = tid >> 6, r32 = lane & 31, hi = lane >> 5;
    const int map = w & 1, qs = w >> 1;
    const bf16_t* QKV = (const bf16_t*)(a.ws + WS_R1);
    const int q0 = qb * 128 + qs * 32;
    const size_t qtok = (size_t)(tok0 + q0 + r32);
    bf16x8 qf[4];
#pragma unroll
    for (int d0 = 0; d0 < 4; ++d0) qf[d0] = *(const bf16x8*)(QKV + qtok * 3072 + h * 128 + map * 64 + 16 * d0 + 8 * hi);
    float qn2 = 0.f;
#pragma unroll
    for (int d0 = 0; d0 < 4; ++d0) { const u32x4 qw = __builtin_bit_cast(u32x4, qf[d0]);
#pragma unroll
        for (int e = 0; e < 4; ++e) { const float x0 = bf_lo(qw[e]), x1 = bf_hi(qw[e]); qn2 += x0 * x0 + x1 * x1; } }
    qn2 += __shfl_xor(qn2, 32);
    const float mref = fminf(sqrtf(qn2) * (map ? km1 : km0) * 1.01f, 40.f);
    asm volatile("" : "+v"(qf[0]), "+v"(qf[1]), "+v"(qf[2]), "+v"(qf[3]));
    const float slope2 = ex2(-(float)(h + 1)) * LOG2E;
    const int lk0 = tid >> 4, lch = tid & 15;
    const bf16_t* kg = QKV + (size_t)(tok0 + kt_lo * 64 + lk0) * 3072 + 1024 + h * 128 + lch * 8;
    const bf16_t* vg = kg + 1024;
    u32x4 kr0 = *(const u32x4*)kg, kr1 = *(const u32x4*)(kg + (size_t)32 * 3072), vr0 = *(const u32x4*)vg, vr1 = *(const u32x4*)(vg + (size_t)32 * 3072);
    LAS unsigned char* stK = lds + lk0 * 272 + lch * 16;
    LAS unsigned char* stV = lds + AT_KB + lk0 * 320 + lch * 16;
    *(LAS u32x4*)stK = kr0; *(LAS u32x4*)(stK + 32 * 272) = kr1; *(LAS u32x4*)stV = vr0; *(LAS u32x4*)(stV + 32 * 320) = vr1;
    __syncthreads();
    f32x16 o[4];
#pragma unroll
    for (int dt = 0; dt < 4; ++dt)
#pragma unroll
        for (int r = 0; r < 16; ++r) o[dt][r] = 0.f;
    float l = 0.f;
    const int i16 = lane & 15, qq = i16 >> 2, p = i16 & 3, g2 = (lane >> 4) & 1;
    for (int kt = kt_lo; kt <= kt_hi; ++kt) {
        const int buf = (kt - kt_lo) & 1;
        if (kt < kt_hi) {
            const size_t off = (size_t)(kt + 1 - kt_lo) * 64 * 3072;
            kr0 = *(const u32x4*)(kg + off); kr1 = *(const u32x4*)(kg + off + (size_t)32 * 3072); vr0 = *(const u32x4*)(vg + off); vr1 = *(const u32x4*)(vg + off + (size_t)32 * 3072);
        }
        LAS const unsigned char* kb = lds + buf * AT_BUF + r32 * 272 + (map * 64 + 8 * hi) * 2;
        f32x16 p0, p1;
        const int kbase = kt * 64;
        const float dbase = (float)(q0 + r32 - kbase - 4 * hi);
        if (kbase > q0 + 31 || kbase + 63 < q0) {
            const float cf_ = (kbase > q0 + 31) ? -slope2 : slope2;
            const float lt = -cf_ * dbase - mref;
#pragma unroll
            for (int r = 0; r < 16; ++r) { const float cc = (float)((r & 3) + 8 * (r >> 2)); p0[r] = cf_ * cc + lt; p1[r] = cf_ * (cc + 32.f) + lt; }
        } else {
#pragma unroll
            for (int r = 0; r < 16; ++r) { const float cc = (float)((r & 3) + 8 * (r >> 2)); p0[r] = -slope2 * __builtin_fabsf(dbase - cc) - mref; p1[r] = -slope2 * __builtin_fabsf(dbase - cc - 32.f) - mref; }
        }
        bf16x8 ka[4], kc[4];
#pragma unroll
        for (int d0 = 0; d0 < 4; ++d0) { ka[d0] = *(LAS const bf16x8*)(kb + d0 * 32); kc[d0] = *(LAS const bf16x8*)(kb + 32 * 272 + d0 * 32); }
        LAS const unsigned char* vbp = lds + buf * AT_BUF + AT_KB + (4 * hi + qq) * 320 + (16 * g2 + 4 * p) * 2;
        s16x4 vl0[4], vh0[4];
#pragma unroll
        for (int dt = 0; dt < 4; ++dt) { vl0[dt] = vtr(vbp + dt * 64); vh0[dt] = vtr(vbp + 8 * 320 + dt * 64); }
        __builtin_amdgcn_sched_barrier(0);
#pragma unroll
        for (int d0 = 0; d0 < 4; ++d0) p0 = mfma32(ka[d0], qf[d0], p0);
#pragma unroll
        for (int d0 = 0; d0 < 4; ++d0) p1 = mfma32(kc[d0], qf[d0], p1);
        bf16x8 pf[4];
        float ls = 0.f;
#pragma unroll
        for (int r = 0; r < 16; ++r) { p0[r] = ex2(p0[r]); ls += p0[r]; }
#pragma unroll
        for (int s = 0; s < 2; ++s) { u32x4 t0;
#pragma unroll
            for (int e = 0; e < 4; ++e) t0[e] = cvtpk(p0[8 * s + 2 * e], p0[8 * s + 2 * e + 1]);
            pf[s] = __builtin_bit_cast(bf16x8, t0); }
#pragma unroll
        for (int dt = 0; dt < 4; ++dt) o[dt] = mfma32(cat8(vl0[dt], vh0[dt]), pf[0], o[dt]);
#pragma unroll
        for (int dt = 0; dt < 4; ++dt) { const s16x4 lo = vtr(vbp + 16 * 320 + dt * 64), hh = vtr(vbp + (16 + 8) * 320 + dt * 64); o[dt] = mfma32(cat8(lo, hh), pf[1], o[dt]); }
#pragma unroll
        for (int r = 0; r < 16; ++r) { p1[r] = ex2(p1[r]); ls += p1[r]; }
#pragma unroll
        for (int s = 0; s < 2; ++s) { u32x4 t1;
#pragma unroll
            for (int e = 0; e < 4; ++e) t1[e] = cvtpk(p1[8 * s + 2 * e], p1[8 * s + 2 * e + 1]);
            pf[2 + s] = __builtin_bit_cast(bf16x8, t1); }
#pragma unroll
        for (int s = 2; s < 4; ++s)
#pragma unroll
            for (int dt = 0; dt < 4; ++dt) { const s16x4 lo = vtr(vbp + (16 * s) * 320 + dt * 64), hh = vtr(vbp + (16 * s + 8) * 320 + dt * 64); o[dt] = mfma32(cat8(lo, hh), pf[s], o[dt]); }
        l += ls;
        if (kt < kt_hi) {
            LAS unsigned char* dK = stK + (buf ^ 1) * AT_BUF; LAS unsigned char* dV = stV + (buf ^ 1) * AT_BUF;
            *(LAS u32x4*)dK = kr0; *(LAS u32x4*)(dK + 32 * 272) = kr1; *(LAS u32x4*)dV = vr0; *(LAS u32x4*)(dV + 32 * 320) = vr1;
        }
        __syncthreads();
    }
    l += __shfl_xor(l, 32);
    const float inv = 1.f / l;
    LAS float* X = (LAS float*)lds + qs * 4096;
    if (map == 1) {
        const float f = lam * inv;
#pragma unroll
        for (int dt = 0; dt < 4; ++dt)
#pragma unroll
            for (int r = 0; r < 16; ++r) X[(dt * 16 + r) * 64 + lane] = o[dt][r] * f;
    }
    __syncthreads();
    if (map == 0) {
        float ss = 0.f;
#pragma unroll
        for (int dt = 0; dt < 4; ++dt)
#pragma unroll
            for (int r = 0; r < 16; ++r) { const float v = o[dt][r] * inv - X[(dt * 16 + r) * 64 + lane]; o[dt][r] = v; ss += v * v; }
        ss += __shfl_xor(ss, 32);
        const float rs = rsqrtf(ss * (1.f / 128.f) + LN_EPS) * (1.f - LAM_INIT);
        bf16_t* O1 = (bf16_t*)((unsigned char*)a.out + OUT_B) + qtok * 1024 + h * 128;
        const float* sg = a.in[21];
#pragma unroll
        for (int dt = 0; dt < 4; ++dt)
#pragma unroll
            for (int rq = 0; rq < 4; ++rq) {
                const int dh = 32 * dt + 8 * rq + 4 * hi; const f32x4 gg = *(const f32x4*)(sg + dh);
                u32x2 wv; wv[0] = cvtpk(o[dt][4 * rq] * rs * gg[0], o[dt][4 * rq + 1] * rs * gg[1]); wv[1] = cvtpk(o[dt][4 * rq + 2] * rs * gg[2], o[dt][4 * rq + 3] * rs * gg[3]);
                *(u32x2*)(O1 + dh) = wv;
            }
    }
    __syncthreads();
}

DI float wave_sum64(float v) {
#pragma unroll
    for (int o = 1; o < 64; o <<= 1) v += __shfl_xor(v, o);
    return v;
}

#define XB_TMO      128
#define XB_XCNT(j)  (256  + 64 * (j))
#define XB_XSUB(j)  (1280 + 64 * (j))
#define XB_XGEN(j)  (2304 + 64 * (j))
#define XB_TOP      3328
#define XB_TOPGEN   3392
#define XCD_BAR_WORDS 3456
#define XB_SPIN_CAP (1u << 22)

__device__ __forceinline__ unsigned xb_ld(unsigned* p)              { return __hip_atomic_load(p, __ATOMIC_RELAXED, __HIP_MEMORY_SCOPE_AGENT); }
__device__ __forceinline__ unsigned xb_add(unsigned* p, unsigned v) { return __hip_atomic_fetch_add(p, v, __ATOMIC_RELAXED, __HIP_MEMORY_SCOPE_AGENT); }
__device__ __forceinline__ unsigned xb_xcc_id() { return (unsigned)__builtin_amdgcn_s_getreg((3 << 11) | 20) & 0xFu; }
#define XB_SPIN(cond, bar) do { unsigned _sp = 0; while (cond) { __builtin_amdgcn_s_sleep(1); \
    if ((++_sp & 255u) == 0u) { if (xb_ld(&(bar)[XB_TMO])) break; if (_sp > XB_SPIN_CAP) { atomicAdd(&(bar)[XB_TMO], 1u); break; } } } } while (0)

struct XcdBarrier {
    unsigned* bar; unsigned x;
    volatile LAS unsigned* st;
};

__device__ __forceinline__ XcdBarrier xcd_barrier_post(unsigned* bar, volatile LAS unsigned* st) {
    XcdBarrier b; b.bar = bar; b.x = xb_xcc_id(); b.st = st;
    if (threadIdx.x == 0) (void)xb_add(&bar[XB_XCNT(b.x)], 1u);
    return b;
}
__device__ __forceinline__ void xcd_barrier_complete(unsigned* bar, unsigned x, unsigned& nloc, unsigned& nx) {
    const unsigned G = gridDim.x * gridDim.y * gridDim.z;
    unsigned sum, cnt, mine, sp = 0u;
    for (;;) {
        sum = 0u; cnt = 0u; mine = 0u;
#pragma unroll
        for (unsigned j = 0; j < 16; ++j) { const unsigned c = xb_ld(&bar[XB_XCNT(j)]); sum += c; cnt += (c > 0u) ? 1u : 0u; mine = (j == x) ? c : mine; }
        if (sum == G) break;
        __builtin_amdgcn_s_sleep(1);
        if ((++sp & 255u) == 0u) { if (xb_ld(&bar[XB_TMO])) break; if (sp > XB_SPIN_CAP) { atomicAdd(&bar[XB_TMO], 1u); break; } }
    }
    nloc = mine > 0u ? mine : 1u; nx = cnt > 0u ? cnt : 1u;
}

__device__ __forceinline__ void xcd_barrier(const XcdBarrier& b) {
    asm volatile("s_waitcnt vmcnt(0)" ::: "memory");
    __syncthreads();
    if (threadIdx.x == 0) {
        unsigned* bar = b.bar;
        __builtin_amdgcn_s_waitcnt(0);
        unsigned nloc = b.st[0], nx = b.st[1];
        if (nloc == 0u) { xcd_barrier_complete(bar, b.x, nloc, nx); b.st[0] = nloc; b.st[1] = nx; }
        const unsigned old = xb_add(&bar[XB_XSUB(b.x)], 1u);
        const unsigned gen = old / nloc;
        if (old + 1u == (gen + 1u) * nloc) {
            __builtin_amdgcn_fence(__ATOMIC_RELEASE, "agent");
            asm volatile("s_waitcnt vmcnt(0)" ::: "memory");
            const unsigned og = xb_add(&bar[XB_TOP], 1u);
            const unsigned tg = og / nx;
            if (og + 1u == (tg + 1u) * nx) xb_add(&bar[XB_TOPGEN], 1u);
            else XB_SPIN(xb_ld(&bar[XB_TOPGEN]) == tg, bar);
            __builtin_amdgcn_fence(__ATOMIC_ACQUIRE, "agent");
            xb_add(&bar[XB_XGEN(b.x)], 1u);
            asm volatile("s_waitcnt vmcnt(0)" ::: "memory");
        } else {
            XB_SPIN(xb_ld(&bar[XB_XGEN(b.x)]) == gen, bar);
            __builtin_amdgcn_fence(__ATOMIC_ACQUIRE, "agent");
            asm volatile("s_waitcnt vmcnt(0)" ::: "memory");
        }
    }
    __syncthreads();
}

__global__ void __launch_bounds__(512, 2) mk_fwd(Args a) {
    extern __shared__ __attribute__((aligned(16))) unsigned char lds_raw[];
    LAS unsigned char* lds = (LAS unsigned char*)lds_raw;
    const int G = gridDim.x, bx = blockIdx.x, tid = threadIdx.x;
    unsigned char* ws = a.ws; unsigned char* ob = (unsigned char*)a.out;
#ifndef PHMASK
#define PHMASK 0xFFFF
#endif
#define IN(k) (((PHMASK >> ((k) & 15)) & 1) && a.ph_lo <= (k) && (k) < a.ph_hi)
#ifndef REPMASK
#define REPMASK 0
#endif
#define REP(k) for (int rep_ = 0; rep_ <= ((REPMASK >> ((k) & 15)) & 1); ++rep_)
#define RSYNC() do { if (rep_) xcd_barrier(bar); } while (0)
#define SEAM(k) do { if (a.ph_lo <= (k) && (k) + 1 < a.ph_hi) xcd_barrier(bar); } while (0)
    float* cf = (float*)(ws + WS_CF);
    if (tid < 16) ((LAS unsigned*)(lds + LDS_BYTES - 64))[tid] = 0u;
    __syncthreads();
    XcdBarrier bar; bar.bar = (unsigned*)(ws + WS_CTL); bar.x = 0; bar.st = (volatile LAS unsigned*)(lds + LDS_BYTES - 64);
    if (a.ph_hi - a.ph_lo > 1) bar = xcd_barrier_post((unsigned*)(ws + WS_CTL), (volatile LAS unsigned*)(lds + LDS_BYTES - 64));
    if (a.ph_hi < 0) cg::this_grid().sync();
    float* stA = (float*)(ws + WS_STA); float* stB = (float*)(ws + WS_STB);

    if (IN(0)) REP(0) { RSYNC(); phase_prologue(a, lds, bx, G); }
    SEAM(0);
    if (IN(1)) REP(1) { RSYNC();
        fold_finalize(a, bx, G);
        pg8::Gemm g{(const bf16_t*)(ob + OUT_A), (const bf16_t*)(ws + WS_WIN0), M, 2560, 1024}; pg8::StaticOrder S; S.init(M, 2560, G, bx);
        EpiIn0 E{(bf16_t*)(ws + WS_R1), (bf16_t*)(ws + WS_R2), (float*)(ws + WS_VST)};
        pg8::gemm_phase<EpiIn0, pg8::StaticOrder, true, true>(lds, g, S, E);
    }
    SEAM(1);
    if (IN(2)) REP(2) { RSYNC();
#ifdef NA_REP
        for (int rr_ = 0; rr_ < NA_REP; ++rr_)
#endif
        for (int u = bx; u < 2048; u += G) na_unit(a, lds, u);
#ifdef GATE_REP
        for (int rr_ = 0; rr_ < GATE_REP; ++rr_)
#endif
        for (int u = bx; u < 1024; u += G) gate_unit(a, lds, u);
    }
    SEAM(2);
    if (IN(3)) REP(3) { RSYNC();
        pg8::Gemm g{(const bf16_t*)(ob + OUT_B), (const bf16_t*)(ws + WS_WOUT0), M, 1024, 1024}; pg8::StaticOrder S; S.init(M, 1024, G, bx);
        EpiRes<0, false> E{a.in[0], a.in[1], nullptr, nullptr, nullptr, nullptr, (bf16_t*)(ws + WS_R1), stA, nullptr, 0};
        pg8::gemm_phase<EpiRes<0, false>, pg8::StaticOrder, true, true>(lds, g, S, E);
    }
    SEAM(3);
#pragma unroll 1
    for (int half = 0; half < 2; ++half) {
        const int p1 = 4 + 2 * half, p2 = 5 + 2 * half, ro = half * MH;
        if (IN(p1)) REP(p1) { RSYNC();
            pg8::Gemm g{(const bf16_t*)(ws + WS_R1) + (size_t)ro * 1024, (const bf16_t*)(ws + WS_WFF1_0), MH, 4096, 1024}; pg8::StaticOrder S; S.init(MH, 4096, G, bx);
            EpiFold<0> E{stA, cf + 0 * 4096, cf + 1 * 4096, (bf16_t*)(ws + WS_R2), 4096, ro, nullptr};
            pg8::gemm_phase<EpiFold<0>, pg8::StaticOrder, true, true>(lds, g, S, E);
        }
        SEAM(p1);
        if (IN(p2)) REP(p2) { RSYNC();
            pg8::Gemm g{(const bf16_t*)(ws + WS_R2), (const bf16_t*)(ws + WS_WFF2_0), MH, 1024, 4096}; pg8::StaticOrder S; S.init(MH, 1024, G, bx);
            EpiRes<1, false> E{nullptr, nullptr, (const bf16_t*)(ws + WS_R1), stA, a.in[9], a.in[10], (bf16_t*)(ob + OUT_A), stB, nullptr, ro};
            pg8::gemm_phase<EpiRes<1, false>, pg8::StaticOrder, true, true>(lds, g, S, E);
        }
        SEAM(p2);
    }
    if (IN(8)) REP(8) { RSYNC();
        pg8::Gemm g{(const bf16_t*)(ob + OUT_A), (const bf16_t*)(ws + WS_WIN1), M, 3072, 1024}; pg8::StaticOrder S; S.init(M, 3072, G, bx);
        EpiFold<1> E{stB, cf + 2 * 4096, cf + 3 * 4096, (bf16_t*)(ws + WS_R1), 3072, 0, (unsigned*)(ws + WS_NRM)};
        pg8::gemm_phase<EpiFold<1>, pg8::StaticOrder, true, true>(lds, g, S, E);
    }
    SEAM(8);
    if (IN(9)) REP(9) { RSYNC();
        const int lane = tid & 63;
        const float d1 = wave_sum64(a.in[17][lane] * a.in[18][lane]), d2 = wave_sum64(a.in[19][lane] * a.in[20][lane]);
        const float lam = __expf(d1) - __expf(d2) + LAM_INIT;
        const unsigned* nrm = (const unsigned*)(ws + WS_NRM);
        unsigned* qheads = (unsigned*)(ws + WS_CTL) + 4096;
        LAS unsigned* qslot = (LAS unsigned*)(lds + LDS_BYTES - 32);
        for (int jq = 0; jq < 8; ++jq) {
          const int x = (bx + jq) & 7, pi = x & 3, b0 = 2 * (x >> 2);
          for (;;) {
            if (tid == 0) *qslot = atomicAdd(qheads + 64 * x, 1u);
            __syncthreads();
            const int idx = (int)*qslot;
            __syncthreads();
            if (idx >= 256) break;
            int tok0, T, h, qb, seq, i2, nqb;
            if (idx < 32) { seq = b0; h = 7 - pi; i2 = idx; nqb = 32; }
            else if (idx < 64) { seq = b0 + 1; h = 4 + pi; i2 = idx - 32; nqb = 32; }
            else if (idx < 128) { seq = 4 + x; h = 7 - ((idx - 64) >> 4); i2 = (idx - 64) & 15; nqb = 16; }
            else if (idx < 160) { seq = b0 + 1; h = 3 - pi; i2 = idx - 128; nqb = 32; }
            else if (idx < 192) { seq = 4 + x; h = 3 - ((idx - 160) >> 4); i2 = (idx - 160) & 15; nqb = 16; }
            else if (idx < 224) { seq = b0; h = pi; i2 = idx - 192; nqb = 32; }
            else { seq = 4 + x; h = 1 - ((idx - 224) >> 4); i2 = (idx - 224) & 15; nqb = 16; }
            qb = (i2 & 1) ? (nqb / 2 - 1 - (i2 >> 1)) : (nqb / 2 + (i2 >> 1));
            if (nqb == 32) { tok0 = seq * 4096; T = 4096; } else { tok0 = MH + (seq - 4) * 2048; T = 2048; }
            const unsigned* nr = nrm + seq * 64 + h * 4;
            float B = 0.f, km[2];
#pragma unroll
            for (int mp = 0; mp < 2; ++mp) {
                const float Q2 = __uint_as_float(nr[mp * 2]) + __uint_as_float(nr[mp * 2 + 1]), K2 = __uint_as_float(nr[32 + mp * 2]) + __uint_as_float(nr[32 + mp * 2 + 1]);
                B = fmaxf(B, 2.04f * sqrtf(Q2 * K2)); km[mp] = sqrtf(K2);
            }
            const float dskip = (64.f + B) / (ex2(-(float)(h + 1)) * LOG2E);
            const int NT = T / 64; int kt_lo = 0, kt_hi = NT - 1;
            if (dskip < 1.0e6f) {
                kt_lo = max(0, (int)floorf(((float)(qb * 128) - dskip - 63.f) * (1.f / 64.f)));
                kt_hi = min(NT - 1, (int)ceilf(((float)(qb * 128 + 127) + dskip) * (1.f / 64.f)));
            }
            attn_unit(a, lds, tok0, h, qb, lam, kt_lo, kt_hi, km[0], km[1]);
          }
        }
    }
    SEAM(9);
    if (IN(10)) REP(10) { RSYNC();
        pg8::Gemm g{(const bf16_t*)(ob + OUT_B), (const bf16_t*)(ws + WS_WOUT1), M, 1024, 1024}; pg8::StaticOrder S; S.init(M, 1024, G, bx);
        EpiRes<1, false> E{nullptr, nullptr, (const bf16_t*)(ob + OUT_A), stB, a.in[13], a.in[14], (bf16_t*)(ws + WS_R1), stA, nullptr, 0};
        pg8::gemm_phase<EpiRes<1, false>, pg8::StaticOrder, true, true>(lds, g, S, E);
    }
    SEAM(10);
#pragma unroll 1
    for (int half = 0; half < 2; ++half) {
        const int p1 = 11 + 2 * half, p2 = 12 + 2 * half, ro = half * MH;
        if (IN(p1)) REP(p1) { RSYNC();
            pg8::Gemm g{(const bf16_t*)(ws + WS_R1) + (size_t)ro * 1024, (const bf16_t*)(ws + WS_WFF1_1), MH, 4096, 1024}; pg8::StaticOrder S; S.init(MH, 4096, G, bx);
            EpiFold<0> E{stA, cf + 4 * 4096, cf + 5 * 4096, (bf16_t*)(ws + WS_R2), 4096, ro, nullptr};
            pg8::gemm_phase<EpiFold<0>, pg8::StaticOrder, true, true>(lds, g, S, E);
        }
        SEAM(p1);
        if (IN(p2)) REP(p2) { RSYNC();
            pg8::Gemm g{(const bf16_t*)(ws + WS_R2), (const bf16_t*)(ws + WS_WFF2_1), MH, 1024, 4096}; pg8::StaticOrder S; S.init(MH, 1024, G, bx);
            EpiRes<1, true> E{nullptr, nullptr, (const bf16_t*)(ws + WS_R1), stA, a.in[22], a.in[23], nullptr, nullptr, a.out, ro};
            pg8::gemm_phase<EpiRes<1, true>, pg8::StaticOrder, true, true>(lds, g, S, E);
        }
        SEAM(p2);
    }
#ifdef EXTRA_SYNCS
    for (int es_ = 0; es_ < EXTRA_SYNCS; ++es_) xcd_barrier(bar);
#endif
    if (IN(15)) {
        const int lane = tid & 63, gw = bx * 8 + (tid >> 6), NGW = G * 8;
        const f32x4* gp = (const f32x4*)a.in[26]; const f32x4* bp = (const f32x4*)a.in[27];
        for (int m = gw; m < M; m += NGW) {
            f32x4* row = (f32x4*)(a.out + (size_t)m * 1024);
            f32x4 v[4]; float s = 0.f;
#pragma unroll
            for (int j = 0; j < 4; ++j) { v[j] = row[lane + 64 * j]; s += (v[j][0] + v[j][1]) + (v[j][2] + v[j][3]); }
            const float mean = wave_sum64(s) * (1.f / 1024.f); float s2 = 0.f;
#pragma unroll
            for (int j = 0; j < 4; ++j) { v[j] = v[j] - mean; s2 += (v[j][0] * v[j][0] + v[j][1] * v[j][1]) + (v[j][2] * v[j][2] + v[j][3] * v[j][3]); }
            const float rstd = rsqrtf(wave_sum64(s2) * (1.f / 1024.f) + LN_EPS);
#pragma unroll
            for (int j = 0; j < 4; ++j) row[lane + 64 * j] = v[j] * rstd * gp[lane + 64 * j] + bp[lane + 64 * j];
        }
    }
#undef IN
#undef SEAM
}

#ifndef MK_PER_PHASE
#define MK_PER_PHASE 0
#endif
extern "C" void kernel_launch(void* const* d_in, const int* in_sizes, int n_in, void* d_out, int out_size, void* d_ws, size_t ws_size, hipStream_t stream) {
    static int grid = 0;
    if (grid == 0) {
        if (n_in != 28 || out_size != M * DM || ws_size < WS_END) { fprintf(stderr, "kernel_launch: unexpected shapes (n_in %d out %d ws %zu)\n", n_in, out_size, ws_size); grid = -1; return; }
        int dev = 0, cus = 0, per_cu = 0;
        (void)hipGetDevice(&dev);
        (void)hipDeviceGetAttribute(&cus, hipDeviceAttributeMultiprocessorCount, dev);
        if (hipFuncSetAttribute((const void*)mk_fwd, hipFuncAttributeMaxDynamicSharedMemorySize, LDS_BYTES) != hipSuccess) { fprintf(stderr, "kernel_launch: hipFuncSetAttribute failed\n"); }
        if (hipOccupancyMaxActiveBlocksPerMultiprocessor(&per_cu, (const void*)mk_fwd, 512, LDS_BYTES) != hipSuccess || per_cu < 1) per_cu = 1;
        (void)hipGetLastError();
        if (cus <= 0) cus = 256;
        grid = cus * per_cu;
    }
    if (grid < 0) return;
    Args a{};
    for (int i = 0; i < 28; ++i) a.in[i] = (const float*)d_in[i];
    a.out = (float*)d_out; a.ws = (unsigned char*)d_ws;
#if MK_PER_PHASE
    for (int p = 0; p < NPHASE; ++p) { a.ph_lo = p; a.ph_hi = p + 1; hipLaunchKernelGGL(mk_fwd, dim3(grid), dim3(512), LDS_BYTES, stream, a); }
#else
    a.ph_lo = 0; a.ph_hi = NPHASE;
    (void)hipMemsetAsync((unsigned char*)d_ws + WS_CTL, 0, 32768, stream);
    void* args[] = {&a};
    hipError_t e = hipLaunchCooperativeKernel((const void*)mk_fwd, dim3(grid), dim3(512), args, LDS_BYTES, stream);
    if (e != hipSuccess) fprintf(stderr, "cooperative launch failed: %s (grid %d)\n", hipGetErrorString(e), grid);
#endif
}
```
